# Optimizing an MI355X kernel written in HIP

```python
import math
import jax, jax.numpy as jnp
from jax import lax
import numpy as np

D_MODEL = 4096
BATCH = 1
SEQ = 8192
DEPTH = 1

HEAD_DIM = 128
N_HEADS_TOTAL = D_MODEL // HEAD_DIM
N_HEADS_A = N_HEADS_TOTAL // 2
N_KV_A = N_HEADS_A // 4
N_HEADS_B = N_HEADS_TOTAL - N_HEADS_A
MIX_WIDTH = (N_HEADS_A + N_HEADS_B) * HEAD_DIM
Q_A = N_HEADS_A * HEAD_DIM
KV_A = N_KV_A * HEAD_DIM
QKV_B = N_HEADS_B * HEAD_DIM
IN_COLS = Q_A + 2 * KV_A + 3 * QKV_B
D_FF = 11008
GRID_W = 64
ROPE_THETA = 10000.0
Q_BLOCK = 128
DILATED_CONFIGS = ((128, 1), (512, 4), (2048, 16))
N_REL_BUCKETS = 32
REL_MAX_DIST = 1024
LN_EPS = 1e-5
RMS_EPS = 1e-6
DEEPNORM_ALPHA = (2.0 * DEPTH) ** 0.25
DEEPNORM_BETA = (8.0 * DEPTH) ** -0.25

kernel_name = "hymba_axial_gqa_dilated_macaron_deepnorm"


def layer_norm(x, g, b):
    xf = x.astype(jnp.float32)
    mu = jnp.mean(xf, axis=-1, keepdims=True)
    var = jnp.mean(jnp.square(xf - mu), axis=-1, keepdims=True)
    return ((xf - mu) * lax.rsqrt(var + LN_EPS) * g + b).astype(x.dtype)


def rms_norm(x, g):
    xf = x.astype(jnp.float32)
    return (xf * lax.rsqrt(jnp.mean(xf * xf, axis=-1, keepdims=True) + RMS_EPS) * g).astype(x.dtype)


def swiglu(x, w_gate, w_up, w_down):
    return (jax.nn.silu(x @ w_gate) * (x @ w_up)) @ w_down


def axial_rope_tables(seq_len):
    rows = seq_len // GRID_W
    row = jnp.repeat(jnp.arange(rows, dtype=jnp.float32), GRID_W)
    col = jnp.tile(jnp.arange(GRID_W, dtype=jnp.float32), rows)
    half = HEAD_DIM // 2
    inv_freq = ROPE_THETA ** (-jnp.arange(0, half, 2, dtype=jnp.float32) / half)
    ang = jnp.concatenate([row[:, None] * inv_freq, col[:, None] * inv_freq], axis=-1)
    return jnp.cos(ang), jnp.sin(ang)


def apply_rope(x, cos, sin):
    xf = x.astype(jnp.float32)
    x1, x2 = xf[..., 0::2], xf[..., 1::2]
    c = cos[None, :, None, :]
    s = sin[None, :, None, :]
    out = jnp.stack([x1 * c - x2 * s, x1 * s + x2 * c], axis=-1).reshape(x.shape)
    return out.astype(x.dtype)


def t5_bucket(rel):
    nb = N_REL_BUCKETS // 2
    max_exact = nb // 2
    ret = jnp.where(rel > 0, nb, 0)
    n = jnp.abs(rel)
    large = max_exact + (jnp.log(jnp.maximum(n, 1).astype(jnp.float32) / max_exact)
                         / math.log(REL_MAX_DIST / max_exact) * (nb - max_exact)).astype(jnp.int32)
    large = jnp.minimum(large, nb - 1)
    return ret + jnp.where(n < max_exact, n, large)


def global_axial_gqa(q, k, v):
    B, S = q.shape[0], q.shape[1]
    nb = S // Q_BLOCK
    rep = N_HEADS_A // N_KV_A
    scale = HEAD_DIM ** -0.5
    qb = q.reshape(B, nb, Q_BLOCK, N_KV_A, rep, HEAD_DIM).transpose(1, 0, 2, 3, 4, 5)

    def block(qi):
        logits = jnp.einsum('bqgrd,bkgd->bgrqk', qi, k).astype(jnp.float32) * scale
        p = jax.nn.softmax(logits, axis=-1).astype(v.dtype)
        return jnp.einsum('bgrqk,bkgd->bqgrd', p, v)

    out = lax.map(block, qb)
    return out.transpose(1, 0, 2, 3, 4, 5).reshape(B, S, Q_A)


def dilated_window_attention(q, k, v, rel_bias):
    B, S = q.shape[0], q.shape[1]
    nb = S // Q_BLOCK
    scale = HEAD_DIM ** -0.5
    qb = q.reshape(B, nb, Q_BLOCK, N_HEADS_B, HEAD_DIM).transpose(1, 0, 2, 3, 4)
    starts = jnp.arange(nb, dtype=jnp.int32) * Q_BLOCK
    offsets = [dil * jnp.arange(-(win // (2 * dil)), win // (2 * dil) + 1, dtype=jnp.int32)
               for win, dil in DILATED_CONFIGS]
    biases = [rel_bias[t5_bucket(off)].astype(jnp.float32).T for off in offsets]

    def block(args):
        qi, start = args
        pos = start + jnp.arange(Q_BLOCK, dtype=jnp.int32)
        outs, lses = [], []
        for off, bias in zip(offsets, biases):
            idx = pos[:, None] + off[None, :]
            valid = (idx >= 0) & (idx < S)
            idxc = jnp.clip(idx, 0, S - 1)
            kg = k[:, idxc]
            vg = v[:, idxc]
            logits = jnp.einsum('bqhd,bqkhd->bqhk', qi, kg).astype(jnp.float32) * scale + bias[None, None]
            logits = jnp.where(valid[None, :, None, :], logits, -jnp.inf)
            m = jnp.max(logits, axis=-1, keepdims=True)
            e = jnp.exp(logits - m)
            s = jnp.sum(e, axis=-1, keepdims=True)
            o = jnp.einsum('bqhk,bqkhd->bqhd', (e / s).astype(v.dtype), vg)
            outs.append(o.astype(jnp.float32))
            lses.append(m[..., 0] + jnp.log(s[..., 0]))
        w = jax.nn.softmax(jnp.stack(lses, axis=0), axis=0)
        return jnp.einsum('nbqh,nbqhd->bqhd', w, jnp.stack(outs, axis=0)).astype(q.dtype)

    out = lax.map(block, (qb, starts))
    return out.transpose(1, 0, 2, 3, 4).reshape(B, S, QKV_B)


def setup_inputs(seed: int = 0) -> dict:
    key = jax.random.key(seed)
    ks = jax.random.split(key, 20)
    f32 = jnp.float32

    def nrm(k, shape, scale):
        return jax.random.normal(k, shape, f32) * scale

    def gain(k, shape):
        return 1.0 + 0.02 * jax.random.normal(k, shape, f32)

    x = jax.random.normal(ks[0], (BATCH, SEQ, D_MODEL), f32)
    beta = DEEPNORM_BETA
    ffn1_w_gate = nrm(ks[1], (DEPTH, D_MODEL, D_FF), D_MODEL ** -0.5)
    ffn1_w_up = nrm(ks[2], (DEPTH, D_MODEL, D_FF), D_MODEL ** -0.5)
    ffn1_w_down = nrm(ks[3], (DEPTH, D_FF, D_MODEL), beta * D_FF ** -0.5)
    ln1_g = gain(ks[4], (DEPTH, D_MODEL))
    ln1_b = nrm(ks[5], (DEPTH, D_MODEL), 0.02)
    col_scale = jnp.concatenate([
        jnp.ones((Q_A + KV_A,), f32), jnp.full((KV_A,), beta, f32),
        jnp.ones((2 * QKV_B,), f32), jnp.full((QKV_B,), beta, f32)])
    w_in = nrm(ks[6], (DEPTH, D_MODEL, IN_COLS), D_MODEL ** -0.5) * col_scale
    q_norm_g = gain(ks[7], (DEPTH, HEAD_DIM))
    k_norm_g = gain(ks[8], (DEPTH, HEAD_DIM))
    rel_bias = nrm(ks[9], (N_REL_BUCKETS, N_HEADS_B), 0.5)
    w_out = nrm(ks[10], (DEPTH, MIX_WIDTH, D_MODEL), beta * MIX_WIDTH ** -0.5)
    ln2_g = gain(ks[11], (DEPTH, D_MODEL))
    ln2_b = nrm(ks[12], (DEPTH, D_MODEL), 0.02)
    ffn2_w_gate = nrm(ks[13], (DEPTH, D_MODEL, D_FF), D_MODEL ** -0.5)
    ffn2_w_up = nrm(ks[14], (DEPTH, D_MODEL, D_FF), D_MODEL ** -0.5)
    ffn2_w_down = nrm(ks[15], (DEPTH, D_FF, D_MODEL), beta * D_FF ** -0.5)
    ln3_g = gain(ks[16], (DEPTH, D_MODEL))
    ln3_b = nrm(ks[17], (DEPTH, D_MODEL), 0.02)
    return {"x": x,
            "ffn1_w_gate": ffn1_w_gate, "ffn1_w_up": ffn1_w_up, "ffn1_w_down": ffn1_w_down,
            "ln1_g": ln1_g, "ln1_b": ln1_b,
            "w_in": w_in, "q_norm_g": q_norm_g, "k_norm_g": k_norm_g,
            "rel_bias": rel_bias, "w_out": w_out,
            "ln2_g": ln2_g, "ln2_b": ln2_b,
            "ffn2_w_gate": ffn2_w_gate, "ffn2_w_up": ffn2_w_up, "ffn2_w_down": ffn2_w_down,
            "ln3_g": ln3_g, "ln3_b": ln3_b}


def reference(x, ffn1_w_gate, ffn1_w_up, ffn1_w_down, ln1_g, ln1_b,
              w_in, q_norm_g, k_norm_g, rel_bias, w_out, ln2_g, ln2_b,
              ffn2_w_gate, ffn2_w_up, ffn2_w_down, ln3_g, ln3_b):
    B, S = x.shape[0], x.shape[1]
    cos, sin = axial_rope_tables(S)
    splits = [Q_A, Q_A + KV_A, Q_A + 2 * KV_A, Q_A + 2 * KV_A + QKV_B, Q_A + 2 * KV_A + 2 * QKV_B]
    h = x
    for l in range(DEPTH):
        h = layer_norm(DEEPNORM_ALPHA * h + 0.5 * swiglu(h, ffn1_w_gate[l], ffn1_w_up[l], ffn1_w_down[l]),
                       ln1_g[l], ln1_b[l])
        proj = h @ w_in[l]
        qa, ka, va, qb, kb, vb = jnp.split(proj, splits, axis=-1)
        qa = apply_rope(rms_norm(qa.reshape(B, S, N_HEADS_A, HEAD_DIM), q_norm_g[l]), cos, sin)
        ka = apply_rope(rms_norm(ka.reshape(B, S, N_KV_A, HEAD_DIM), k_norm_g[l]), cos, sin)
        va = va.reshape(B, S, N_KV_A, HEAD_DIM)
        out_a = global_axial_gqa(qa, ka, va)
        out_b = dilated_window_attention(qb.reshape(B, S, N_HEADS_B, HEAD_DIM),
                                         kb.reshape(B, S, N_HEADS_B, HEAD_DIM),
                                         vb.reshape(B, S, N_HEADS_B, HEAD_DIM), rel_bias)
        mix = jnp.concatenate([out_a, out_b], axis=-1) @ w_out[l]
        h = layer_norm(DEEPNORM_ALPHA * h + mix, ln2_g[l], ln2_b[l])
        h = layer_norm(DEEPNORM_ALPHA * h + 0.5 * swiglu(h, ffn2_w_gate[l], ffn2_w_up[l], ffn2_w_down[l]),
                       ln3_g[l], ln3_b[l])
    return h
```

```cpp
#include <hip/hip_runtime.h>
#include <hip/hip_bf16.h>
#include <cstdio>
#include <cstdint>
#include <cmath>
namespace pg8 {
#define PG8_LAS __attribute__((address_space(3)))
typedef unsigned short bf16_t;
typedef short bf16x8 __attribute__((ext_vector_type(8)));
typedef float f32x4 __attribute__((ext_vector_type(4)));
typedef unsigned u32x4 __attribute__((ext_vector_type(4)));
constexpr int BM = 256, BK = 64, HALF = 128, HTB = HALF * BK * 2  , STAGE_BYTES = 8 * HTB, NXCD = 8, WGM = 8;

__host__ __device__ __forceinline__ int lds_byte(int r, int c) { const int st = (r >> 4) * 2 + (c >> 5), rr = r & 15, cc = c & 31, ob = rr * 64 + cc * 2; return st * 1024 + (ob ^ (((ob >> 9) & 1) << 5)); }
__host__ __device__ __forceinline__ void stage_rc(int b, int& R, int& C) { const int st = b / 1024, sb = b % 1024, swz = sb ^ (((sb >> 9) & 1) << 5); R = (st >> 1) * 16 + swz / 64; C = (st & 1) * 32 + (swz % 64) / 2; }
__host__ __device__ __forceinline__ int perm32(int rho) { const int n = rho >> 4, i = rho & 15; return 8 * (i >> 2) + 4 * n + (i & 3); }

struct Unit { int pm, pn; };
struct Gemm { const bf16_t* A; const bf16_t* Bt; int M, N, K; };

struct StaticOrder {
    int nM, nN, nwg, G, c;
    __host__ __device__ void init(int M, int N, int G_, int c_) { nM = M / BM; nN = N / BM; nwg = nM * nN; G = G_; c = c_; }
    __host__ __device__ bool next(int i, Unit& u) const {
        const long L = (long)i * G + c; if (L >= nwg) return false;
        int wgid = (int)L; { const int q = nwg / NXCD, r = nwg % NXCD, xcd = wgid % NXCD, off = wgid / NXCD; wgid = (xcd < r ? xcd * (q + 1) : r * (q + 1) + (xcd - r) * q) + off; }
        const int nig = WGM * nN, gid = wgid / nig, fm = gid * WGM, gsz = (nM - fm) < WGM ? (nM - fm) : WGM;
        u.pm = fm + ((wgid % nig) % gsz); u.pn = (wgid % nig) / gsz; return true;
    }
    __device__ __forceinline__ void a_ready(const Unit&) const {}
    __device__ __forceinline__ void done(const Unit&) const {}
};

__device__ __forceinline__ unsigned cvt_pk_bf16(float lo, float hi) { unsigned r; asm volatile("v_cvt_pk_bf16_f32 %0, %1, %2" : "=v"(r) : "v"(lo), "v"(hi)); return r; }
struct EpiBf16 {
    static constexpr bool PERM = true, AFTER_DRAIN = false;
    bf16_t* O; int ldc;
    __device__ __forceinline__ void operator()(const f32x4 (&acc)[2][2][4][2], const Unit& u, int wr, int wc, int fr, int fq) const {
        const int row0 = u.pm * BM + wr * 64 + fr, col0 = u.pn * BM + wc * 32 + 8 * fq;
#pragma unroll
        for (int ai = 0; ai < 2; ++ai)
#pragma unroll
            for (int m = 0; m < 4; ++m) { bf16_t* rowp = O + (size_t)(row0 + ai * HALF + m * 16) * ldc + col0;
#pragma unroll
                for (int bj = 0; bj < 2; ++bj) { const f32x4 v0 = acc[ai][bj][m][0], v1 = acc[ai][bj][m][1];
                    u32x4 w; w.x = cvt_pk_bf16(v0[0], v0[1]); w.y = cvt_pk_bf16(v0[2], v0[3]); w.z = cvt_pk_bf16(v1[0], v1[1]); w.w = cvt_pk_bf16(v1[2], v1[3]);
                    *(u32x4*)(rowp + bj * HALF) = w; } }
    }
};
__device__ __forceinline__ float silu_mul(float g, float u) { return g * __builtin_amdgcn_rcpf(1.0f + __builtin_amdgcn_exp2f(g * -1.4426950408889634f)) * u; }
struct EpiSwiGLU {
    static constexpr bool PERM = true, AFTER_DRAIN = false;
    bf16_t* O; int ldc;
    __device__ __forceinline__ void operator()(const f32x4 (&acc)[2][2][4][2], const Unit& u, int wr, int wc, int fr, int fq) const {
        const int row0 = u.pm * BM + wr * 64 + fr, col0 = u.pn * HALF + wc * 32 + 8 * fq;
#pragma unroll
        for (int ai = 0; ai < 2; ++ai)
#pragma unroll
            for (int m = 0; m < 4; ++m) { bf16_t* rowp = O + (size_t)(row0 + ai * HALF + m * 16) * ldc + col0;
                const f32x4 g0 = acc[ai][0][m][0], g1 = acc[ai][0][m][1], u0 = acc[ai][1][m][0], u1 = acc[ai][1][m][1];
                u32x4 w; w.x = cvt_pk_bf16(silu_mul(g0[0], u0[0]), silu_mul(g0[1], u0[1])); w.y = cvt_pk_bf16(silu_mul(g0[2], u0[2]), silu_mul(g0[3], u0[3]));
                w.z = cvt_pk_bf16(silu_mul(g1[0], u1[0]), silu_mul(g1[1], u1[1])); w.w = cvt_pk_bf16(silu_mul(g1[2], u1[2]), silu_mul(g1[3], u1[3]));
                *(u32x4*)rowp = w; }
    }
};
struct EpiRes {
    static constexpr bool PERM = false, AFTER_DRAIN = false;
    const float* R; float* Y; int ldc; float ra, sa;
    __device__ __forceinline__ void operator()(const f32x4 (&acc)[2][2][4][2], const Unit& u, int wr, int wc, int fr, int fq) const {
        const int row0 = u.pm * BM + wr * 64 + fr, col0 = u.pn * BM + wc * 32 + 4 * fq;
#pragma unroll
        for (int ai = 0; ai < 2; ++ai)
#pragma unroll
            for (int m = 0; m < 4; ++m) { const size_t off = (size_t)(row0 + ai * HALF + m * 16) * ldc + col0;
                f32x4 rv[2][2];
#pragma unroll
                for (int bj = 0; bj < 2; ++bj)
#pragma unroll
                    for (int n = 0; n < 2; ++n) rv[bj][n] = *(const f32x4*)(R + off + bj * HALF + n * 16);
#pragma unroll
                for (int bj = 0; bj < 2; ++bj)
#pragma unroll
                    for (int n = 0; n < 2; ++n) *(f32x4*)(Y + off + bj * HALF + n * 16) = rv[bj][n] * ra + acc[ai][bj][m][n] * sa;
                if (m & 1) asm volatile("" ::: "memory"); }
    }
};

template <class Epi, class Sched, bool ALIGN_EPI = false, bool SP2 = false>
__device__ __forceinline__ void gemm_phase(PG8_LAS unsigned char* lds, const Gemm g, const Sched& S, const Epi& E) {
    int tid_ = threadIdx.x; asm volatile("" : "+v"(tid_));
    const int tid = tid_, wid = __builtin_amdgcn_readfirstlane(tid >> 6), lane = tid & 63, wr = wid >> 2, wc = wid & 3, fr = lane & 15, fq = lane >> 4;
    const int K = g.K, nt = K / BK;
    unsigned voffA[2], voffB[2];
#pragma unroll
    for (int i = 0; i < 2; ++i) { int R, C; stage_rc(tid * 16 + i * 8192, R, C); const int Rb = Epi::PERM ? ((R & ~31) + perm32(R & 31)) : R;
        voffA[i] = (unsigned)(R * K + C) * 2u; voffB[i] = (unsigned)(Rb * K + C) * 2u; }
    const size_t kstep = (size_t)(BK * 2);
    const size_t hstep = (size_t)HALF * K * 2;
    const size_t tstep = 2 * hstep;
    const unsigned ldsw = (unsigned)wid * 1024u;
    const int aoff = lds_byte(wr * 64 + fr, fq * 8), boff = lds_byte(wc * 32 + fr, fq * 8);
#define PG8_SA(b, h) (((b) * 2 + (h)) * HTB)
#define PG8_SB(b, h) ((4 + (b) * 2 + (h)) * HTB)
#define PG8_STAGE(bufoff, gbase, voff) do { _Pragma("unroll") for (int _i = 0; _i < 2; ++_i) \
        __builtin_amdgcn_global_load_lds((const unsigned*)((const char*)(gbase) + (voff)[_i]), (PG8_LAS unsigned*)(lds + (bufoff) + ldsw + _i * 8192), 16, 0, 0); } while (0)
#define PG8_LDA(dst, b, h) do { _Pragma("unroll") for (int m = 0; m < 4; ++m) _Pragma("unroll") for (int k = 0; k < 2; ++k) dst[m][k] = *(const PG8_LAS bf16x8*)(lds + PG8_SA(b, h) + aoff + m * 2048 + k * 1024); } while (0)
#define PG8_LDB(dst, b, h) do { _Pragma("unroll") for (int n = 0; n < 2; ++n) _Pragma("unroll") for (int k = 0; k < 2; ++k) dst[n][k] = *(const PG8_LAS bf16x8*)(lds + PG8_SB(b, h) + boff + n * 2048 + k * 1024); } while (0)
#define PG8_MMA(ai, bj, At, Bt) do { __builtin_amdgcn_s_setprio(1); _Pragma("unroll") for (int m = 0; m < 4; ++m) _Pragma("unroll") for (int n = 0; n < 2; ++n) _Pragma("unroll") for (int k = 0; k < 2; ++k) \
        acc[ai][bj][m][n] = __builtin_amdgcn_mfma_f32_16x16x32_bf16(Bt[n][k], At[m][k], acc[ai][bj][m][n], 0, 0, 0); __builtin_amdgcn_s_setprio(0); } while (0)
#define PG8_WAIT_V(n) asm volatile("s_waitcnt vmcnt(" #n ")" ::: "memory")
#define PG8_WAIT_L(n) asm volatile("s_waitcnt lgkmcnt(" #n ")" ::: "memory")
#define PG8_BAR __builtin_amdgcn_s_barrier()
#define PG8_SCHED __builtin_amdgcn_sched_barrier(0)
    Unit cur, nxt; int ui = 0;
    if (!S.next(0, cur)) return;
    f32x4 acc[2][2][4][2];
#pragma unroll
    for (int a = 0; a < 2; ++a)
#pragma unroll
        for (int b = 0; b < 2; ++b)
#pragma unroll
            for (int m = 0; m < 4; ++m)
#pragma unroll
                for (int n = 0; n < 2; ++n) acc[a][b][m][n] = (f32x4){0.f, 0.f, 0.f, 0.f};
    bf16x8 At[4][2], B0[2][2], B1[2][2];
    const char* cA = (const char*)g.A + (size_t)cur.pm * tstep; const char* cB = (const char*)g.Bt + (size_t)cur.pn * tstep;
    S.a_ready(cur);
    if constexpr (SP2) {
        PG8_STAGE(PG8_SB(0, 0), cB, voffB); PG8_STAGE(PG8_SB(0, 1), cB + hstep, voffB); PG8_STAGE(PG8_SA(0, 0), cA, voffA); PG8_STAGE(PG8_SA(0, 1), cA + hstep, voffA);
        if (wr == 1) PG8_BAR;
        PG8_WAIT_V(2); PG8_BAR;
        PG8_STAGE(PG8_SB(1, 0), cB + kstep, voffB); PG8_STAGE(PG8_SA(1, 0), cA + kstep, voffA); PG8_STAGE(PG8_SB(1, 1), cB + hstep + kstep, voffB);
        PG8_WAIT_V(6); PG8_BAR;
    } else {
        PG8_STAGE(PG8_SB(0, 0), cB, voffB); PG8_STAGE(PG8_SA(0, 0), cA, voffA); PG8_STAGE(PG8_SB(0, 1), cB + hstep, voffB); PG8_STAGE(PG8_SA(0, 1), cA + hstep, voffA);
        if (wr == 1) PG8_BAR;
        PG8_WAIT_V(4); PG8_BAR;
        PG8_STAGE(PG8_SB(1, 0), cB + kstep, voffB); PG8_STAGE(PG8_SA(1, 0), cA + kstep, voffA); PG8_STAGE(PG8_SB(1, 1), cB + hstep + kstep, voffB);
        PG8_WAIT_V(6); PG8_BAR;
    }
    for (;;) {
        const bool has_next = S.next(ui + 1, nxt);
        const char* nA = has_next ? (const char*)g.A + (size_t)nxt.pm * tstep : cA; const char* nB = has_next ? (const char*)g.Bt + (size_t)nxt.pn * tstep : cB;
        for (int t = 0; t < nt; t += 2) {
            const bool last = (t == nt - 2);
            const char* a1 = cA + (size_t)(t + 1) * kstep;
            const char* a2 = last ? nA : cA + (size_t)(t + 2) * kstep; const char* b2 = last ? nB : cB + (size_t)(t + 2) * kstep;
            const char* a3 = a2 + kstep; const char* b3 = b2 + kstep;
            if (last && has_next) S.a_ready(nxt);
            if constexpr (SP2) {
            PG8_LDB(B0, 0, 0); PG8_LDB(B1, 0, 1); PG8_SCHED; PG8_LDA(At, 0, 0); PG8_STAGE(PG8_SA(1, 1), a1 + hstep, voffA);
            PG8_WAIT_V(8); PG8_WAIT_L(0); PG8_BAR; PG8_MMA(0, 0, At, B0); PG8_MMA(0, 1, At, B1); PG8_BAR; PG8_SCHED;
            PG8_LDA(At, 0, 1); PG8_STAGE(PG8_SB(0, 0), b2, voffB); PG8_STAGE(PG8_SB(0, 1), b2 + hstep, voffB); PG8_STAGE(PG8_SA(0, 0), a2, voffA);
            PG8_WAIT_V(8); PG8_WAIT_L(0); PG8_BAR; PG8_MMA(1, 0, At, B0); PG8_MMA(1, 1, At, B1); PG8_BAR; PG8_SCHED;
            PG8_LDB(B0, 1, 0); PG8_LDB(B1, 1, 1); PG8_SCHED; PG8_LDA(At, 1, 0); PG8_STAGE(PG8_SA(0, 1), a2 + hstep, voffA);
            PG8_WAIT_V(8); PG8_WAIT_L(0); PG8_BAR; PG8_MMA(0, 0, At, B0); PG8_MMA(0, 1, At, B1); PG8_BAR; PG8_SCHED;
            PG8_LDA(At, 1, 1); PG8_STAGE(PG8_SB(1, 0), b3, voffB); PG8_STAGE(PG8_SB(1, 1), b3 + hstep, voffB); PG8_STAGE(PG8_SA(1, 0), a3, voffA);
            PG8_WAIT_V(8); PG8_WAIT_L(0); PG8_BAR; PG8_MMA(1, 0, At, B0); PG8_MMA(1, 1, At, B1); PG8_BAR; PG8_SCHED;
            } else {
            PG8_LDB(B0, 0, 0); PG8_SCHED; PG8_LDA(At, 0, 0); PG8_STAGE(PG8_SA(1, 1), a1 + hstep, voffA);
            PG8_WAIT_L(8); PG8_BAR; PG8_WAIT_L(0); PG8_MMA(0, 0, At, B0); PG8_BAR; PG8_SCHED;
            PG8_LDB(B1, 0, 1); PG8_STAGE(PG8_SB(0, 0), b2, voffB);
            PG8_BAR; PG8_WAIT_L(0); PG8_MMA(0, 1, At, B1); PG8_BAR;
            PG8_LDA(At, 0, 1); PG8_STAGE(PG8_SA(0, 0), a2, voffA);
            PG8_BAR; PG8_WAIT_L(0); PG8_MMA(1, 0, At, B0); PG8_BAR; PG8_SCHED;
            PG8_STAGE(PG8_SB(0, 1), b2 + hstep, voffB);
            PG8_WAIT_V(6); PG8_BAR; PG8_MMA(1, 1, At, B1); PG8_BAR;
            PG8_LDB(B0, 1, 0); PG8_SCHED; PG8_LDA(At, 1, 0); PG8_STAGE(PG8_SA(0, 1), a2 + hstep, voffA);
            PG8_WAIT_L(8); PG8_BAR; PG8_WAIT_L(0); PG8_MMA(0, 0, At, B0); PG8_BAR; PG8_SCHED;
            PG8_LDB(B1, 1, 1); PG8_STAGE(PG8_SB(1, 0), b3, voffB);
            PG8_BAR; PG8_WAIT_L(0); PG8_MMA(0, 1, At, B1); PG8_BAR;
            PG8_LDA(At, 1, 1); PG8_STAGE(PG8_SA(1, 0), a3, voffA);
            PG8_BAR; PG8_WAIT_L(0); PG8_MMA(1, 0, At, B0); PG8_BAR; PG8_SCHED;
            PG8_STAGE(PG8_SB(1, 1), b3 + hstep, voffB);
            PG8_WAIT_V(6); PG8_BAR; PG8_MMA(1, 1, At, B1); PG8_BAR;
            }
        }
        if constexpr (ALIGN_EPI) { if (wr == 0) PG8_BAR; }
        if constexpr (!Epi::AFTER_DRAIN) { E(acc, cur, wr, wc, fr, fq); S.done(cur); }
        if (!has_next) break;
#pragma unroll
        for (int a = 0; a < 2; ++a)
#pragma unroll
            for (int b = 0; b < 2; ++b)
#pragma unroll
                for (int m = 0; m < 4; ++m)
#pragma unroll
                    for (int n = 0; n < 2; ++n) acc[a][b][m][n] = (f32x4){0.f, 0.f, 0.f, 0.f};
        cur = nxt; cA = nA; cB = nB; ++ui;
        if constexpr (ALIGN_EPI) { if (wr == 1) PG8_BAR; }
    }
    PG8_WAIT_V(0);
    if constexpr (!ALIGN_EPI) { if (wr == 0) PG8_BAR; }
    PG8_BAR;
    if constexpr (Epi::AFTER_DRAIN) { E.fused(acc, cur, wr, wc, fr, fq, lds, wid, lane); S.done(cur); }
#undef PG8_SA
#undef PG8_SB
#undef PG8_STAGE
#undef PG8_LDA
#undef PG8_LDB
#undef PG8_MMA
#undef PG8_WAIT_V
#undef PG8_WAIT_L
#undef PG8_BAR
#undef PG8_SCHED
}
}
namespace att {
typedef unsigned short bf16_t;
using bf16x8 = __attribute__((ext_vector_type(8))) short;
using s16x4  = __attribute__((ext_vector_type(4))) short;
using f32x16 = __attribute__((ext_vector_type(16))) float;
using u32x4  = __attribute__((ext_vector_type(4))) unsigned;
constexpr int   D = 128, NW = 8, QBLK = 32, KVBLK = 64;
constexpr float SCALE = 0.088388347648318440f, LOG2E = 1.4426950408889634f;
constexpr float THR = 8.f;
constexpr int LDQ = 9216, LDK = 9216, LDO = 4096;
constexpr int SHM_V = KVBLK * D * 2, SHM_K = KVBLK * D * 2;
constexpr int OFF_WS = 2 * SHM_V + 2 * SHM_K, OFF_TB = OFF_WS + NW * 64 * 4, TBN = 2560, TB0 = 1280, SHM_ATTN = OFF_TB + TBN * 4;
#define KSWZ(row, colB) ((row) * 256 + ((colB) ^ (((row) & 7) << 4)))
#define SBAR() __builtin_amdgcn_sched_barrier(0)
__device__ __forceinline__ int crow(int r, int hi) { return (r & 3) + 8 * (r >> 2) + 4 * hi; }
__device__ __forceinline__ unsigned cvtpk(float lo, float hi) { unsigned r; asm volatile("v_cvt_pk_bf16_f32 %0, %1, %2" : "=v"(r) : "v"(lo), "v"(hi)); return r; }
__device__ __forceinline__ void partialSM(f32x16& p0, f32x16& p1, float& m_reg, float& mn, float& alpha) {
  constexpr float C = SCALE * LOG2E;
  float pmax = p0[0];
#pragma unroll
  for (int r = 1; r < 16; ++r) pmax = fmaxf(pmax, p0[r]);
#pragma unroll
  for (int r = 0; r < 16; ++r) pmax = fmaxf(pmax, p1[r]);
  { auto rr = __builtin_amdgcn_permlane32_swap(__float_as_uint(pmax), __float_as_uint(pmax), false, false);
    pmax = fmaxf(__uint_as_float(rr[0]), __uint_as_float(rr[1])); }
  if (__builtin_expect(__all(pmax - m_reg <= THR / SCALE), 1)) { mn = m_reg; alpha = 1.f; }
  else { mn = fmaxf(m_reg, pmax); alpha = __builtin_amdgcn_exp2f((m_reg - mn) * C); m_reg = mn; }
  const float mnC = -mn * C;
#pragma unroll
  for (int r = 0; r < 16; ++r) p0[r] = fmaf(p0[r], C, mnC);
#pragma unroll
  for (int r = 0; r < 16; ++r) p1[r] = fmaf(p1[r], C, mnC);
#pragma unroll
  for (int r = 0; r < 16; ++r) p0[r] = __builtin_amdgcn_exp2f(p0[r]);
}
__device__ __forceinline__ void partialSM_b(f32x16& p0, f32x16& p1, float& m_reg, float& mn, float& alpha, const float* tbp) {
  constexpr float C = SCALE * LOG2E;
#pragma unroll
  for (int r = 0; r < 16; ++r) { const int o = (r & 3) + 8 * (r >> 2); p0[r] = fmaf(p0[r], C, tbp[o]); p1[r] = fmaf(p1[r], C, tbp[32 + o]); }
  float pmax = p0[0];
#pragma unroll
  for (int r = 1; r < 16; ++r) pmax = fmaxf(pmax, p0[r]);
#pragma unroll
  for (int r = 0; r < 16; ++r) pmax = fmaxf(pmax, p1[r]);
  { auto rr = __builtin_amdgcn_permlane32_swap(__float_as_uint(pmax), __float_as_uint(pmax), false, false);
    pmax = fmaxf(__uint_as_float(rr[0]), __uint_as_float(rr[1])); }
  if (__builtin_expect(__all(pmax - m_reg <= THR * LOG2E), 1)) { mn = m_reg; alpha = 1.f; }
  else { mn = fmaxf(m_reg, pmax); alpha = __builtin_amdgcn_exp2f(m_reg - mn); m_reg = mn; }
#pragma unroll
  for (int r = 0; r < 16; ++r) p0[r] = p0[r] - mn;
#pragma unroll
  for (int r = 0; r < 16; ++r) p1[r] = p1[r] - mn;
#pragma unroll
  for (int r = 0; r < 16; ++r) p0[r] = __builtin_amdgcn_exp2f(p0[r]);
}
__device__ __forceinline__ void finishSM(f32x16& p0, f32x16& p1, float alpha, float& l_reg, bf16x8& pa0, bf16x8& pa1, bf16x8& pa2, bf16x8& pa3) {
#pragma unroll
  for (int r = 0; r < 16; ++r) p1[r] = __builtin_amdgcn_exp2f(p1[r]);
  float ps = 0;
#pragma unroll
  for (int r = 0; r < 16; ++r) ps += p0[r];
#pragma unroll
  for (int r = 0; r < 16; ++r) ps += p1[r];
  { auto rr = __builtin_amdgcn_permlane32_swap(__float_as_uint(ps), __float_as_uint(ps), false, false);
    ps = __uint_as_float(rr[0]) + __uint_as_float(rr[1]); }
  l_reg = l_reg * alpha + ps;
#define PK4(P, BASE, OUT) do { unsigned a0 = cvtpk(P[BASE + 0], P[BASE + 1]), a1 = cvtpk(P[BASE + 2], P[BASE + 3]);   \
    unsigned b0 = cvtpk(P[BASE + 4], P[BASE + 5]), b1 = cvtpk(P[BASE + 6], P[BASE + 7]);                              \
    auto r0 = __builtin_amdgcn_permlane32_swap(a0, b0, false, false); auto r1 = __builtin_amdgcn_permlane32_swap(a1, b1, false, false); \
    u32x4 w = {r0[0], r1[0], r0[1], r1[1]}; OUT = *reinterpret_cast<bf16x8*>(&w); } while (0)
  PK4(p0, 0, pa0); PK4(p0, 8, pa1); PK4(p1, 0, pa2); PK4(p1, 8, pa3);
#undef PK4
}
__device__ __forceinline__ void qkt(f32x16& p0, f32x16& p1, const char* Ks, const bf16x8* qr, int r32, int hi) {
  p0 = f32x16{}; p1 = f32x16{};
#pragma unroll
  for (int d0 = 0; d0 < 8; ++d0) { const int cb = (d0 * 16 + hi * 8) * 2;
    const bf16x8 b0 = *reinterpret_cast<const bf16x8*>(Ks + KSWZ(r32, cb));
    const bf16x8 b1 = *reinterpret_cast<const bf16x8*>(Ks + KSWZ(32 + r32, cb));
    p0 = __builtin_amdgcn_mfma_f32_32x32x16_bf16(b0, qr[d0], p0, 0, 0, 0);
    p1 = __builtin_amdgcn_mfma_f32_32x32x16_bf16(b1, qr[d0], p1, 0, 0, 0); }
}
__device__ __forceinline__ int v_st(int k, int c) { const int kk = (k & ~0xC) | ((k & 4) << 1) | ((k & 8) >> 1); return ((kk >> 3) * 4 + (c >> 5)) * 512 + ((kk & 7) * 32 + (c & 31)) * 2; }
__device__ __forceinline__ int v_rd_base(int lane) { return ((lane & 3) << 3) | (((lane >> 2) & 3) << 6) | (((lane >> 4) & 1) << 5) | (((lane >> 5) & 1) << 8); }
constexpr int v_rd_off(int d0, int ks, int half) { return d0 * 512 + ks * 4096 + half * 2048; }
template <int OFF> __device__ __forceinline__ s16x4 tr_read(int vb) {
  s16x4 r; asm volatile("ds_read_b64_tr_b16 %0, %1 offset:%2" : "=&v"(r) : "v"(vb), "i"(OFF) : "memory"); return r;
}
template <int D0> __device__ __forceinline__ void pv_one(f32x16& od, int vb, bf16x8 pa0, bf16x8 pa1, bf16x8 pa2, bf16x8 pa3) {
  const s16x4 l0 = tr_read<v_rd_off(D0, 0, 0)>(vb), h0 = tr_read<v_rd_off(D0, 0, 1)>(vb), l1 = tr_read<v_rd_off(D0, 1, 0)>(vb), h1 = tr_read<v_rd_off(D0, 1, 1)>(vb);
  const s16x4 l2 = tr_read<v_rd_off(D0, 2, 0)>(vb), h2 = tr_read<v_rd_off(D0, 2, 1)>(vb), l3 = tr_read<v_rd_off(D0, 3, 0)>(vb), h3 = tr_read<v_rd_off(D0, 3, 1)>(vb);
  asm volatile("s_waitcnt lgkmcnt(0)" ::: "memory"); SBAR();
#define PK(L, H) (bf16x8){L[0], L[1], L[2], L[3], H[0], H[1], H[2], H[3]}
  od = __builtin_amdgcn_mfma_f32_32x32x16_bf16(pa0, PK(l0, h0), od, 0, 0, 0);
  od = __builtin_amdgcn_mfma_f32_32x32x16_bf16(pa1, PK(l1, h1), od, 0, 0, 0);
  od = __builtin_amdgcn_mfma_f32_32x32x16_bf16(pa2, PK(l2, h2), od, 0, 0, 0);
  od = __builtin_amdgcn_mfma_f32_32x32x16_bf16(pa3, PK(l3, h3), od, 0, 0, 0);
#undef PK
}
__device__ __forceinline__ void pv_d0(f32x16* o, int vb, bf16x8 pa0, bf16x8 pa1, bf16x8 pa2, bf16x8 pa3) {
  pv_one<0>(o[0], vb, pa0, pa1, pa2, pa3); pv_one<1>(o[1], vb, pa0, pa1, pa2, pa3); pv_one<2>(o[2], vb, pa0, pa1, pa2, pa3); pv_one<3>(o[3], vb, pa0, pa1, pa2, pa3);
}
template <bool BIAS, int SDEPTH>
__device__ __forceinline__ void attn_body(const bf16_t* __restrict__ Qb, const bf16_t* __restrict__ Kh, const bf16_t* __restrict__ Vh, bf16_t* __restrict__ Ob, int NT, int koff, char* lds) {
  int tid_ = threadIdx.x; asm volatile("" : "+v"(tid_));
  const int tid = tid_, wid = tid >> 6, lane = tid & 63, r32 = lane & 31, hi = lane >> 5;
  char* V_lds = lds; char* K_lds = lds + 2 * SHM_V;
  float* ws = (float*)(lds + OFF_WS) + wid * 64; float* li_l = ws; float* al_l = ws + 32;
  const float* tb0 = (const float*)(lds + OFF_TB) + (koff + TB0 - (wid * QBLK + r32) + 4 * hi);
  float m_reg = -1e30f, l_reg = 0; f32x16 o[4] = {}; bf16x8 qr[8];
  const bf16_t* Qw = Qb + (long)(wid * QBLK + r32) * LDQ + hi * 8;
#pragma unroll
  for (int d0 = 0; d0 < 8; ++d0) qr[d0] = *reinterpret_cast<const bf16x8*>(Qw + d0 * 16);
  const int sr = tid >> 4, sc = (tid & 15) * 8, vst0 = v_st(sr, sc), vst1 = v_st(32 + sr, sc);
  const int vb0 = (int)(uintptr_t)V_lds + v_rd_base(lane);
  struct { bf16x8 vs0, vs1, ks0, ks1; } sr_[SDEPTH];
#define SLOAD(i, k0) do { sr_[i].vs0 = *reinterpret_cast<const bf16x8*>(&Vh[(long)((k0) + sr) * LDK + sc]); sr_[i].vs1 = *reinterpret_cast<const bf16x8*>(&Vh[(long)((k0) + 32 + sr) * LDK + sc]); \
    sr_[i].ks0 = *reinterpret_cast<const bf16x8*>(&Kh[(long)((k0) + sr) * LDK + sc]); sr_[i].ks1 = *reinterpret_cast<const bf16x8*>(&Kh[(long)((k0) + 32 + sr) * LDK + sc]); } while (0)
#define SWRITE(b, i) do { *(bf16x8*)(V_lds + (b) * SHM_V + vst0) = sr_[i].vs0;          \
    *(bf16x8*)(V_lds + (b) * SHM_V + vst1) = sr_[i].vs1; const int kc = sc * 2;               \
    *(bf16x8*)(K_lds + (b) * SHM_K + KSWZ(sr, kc)) = sr_[i].ks0;                       \
    *(bf16x8*)(K_lds + (b) * SHM_K + KSWZ(32 + sr, kc)) = sr_[i].ks1; } while (0)
#define SWAIT() do { if constexpr (SDEPTH == 2) asm volatile("s_waitcnt vmcnt(4)" ::: "memory"); else asm volatile("s_waitcnt vmcnt(0)" ::: "memory"); } while (0)
#define RESC(a) do { if (__any((a) < 1.f)) { if (hi == 0) al_l[r32] = (a); asm volatile("s_waitcnt lgkmcnt(0)" ::: "memory"); \
    _Pragma("unroll") for (int d = 0; d < 4; ++d) _Pragma("unroll") for (int r = 0; r < 16; ++r) o[d][r] *= al_l[crow(r, hi)]; } } while (0)
#define PSM(P0, P1, MN, AL, t) do { if constexpr (BIAS) partialSM_b(P0, P1, m_reg, MN, AL, tb0 + (t) * KVBLK); else partialSM(P0, P1, m_reg, MN, AL); } while (0)
  f32x16 pA0, pA1, pB0, pB1; float mnA, mnB, alA, alB; bf16x8 pa0, pa1, pa2, pa3;
  constexpr int SE = 0, SO = SDEPTH - 1;
  SLOAD(SE, 0); asm volatile("s_waitcnt vmcnt(0)" ::: "memory"); SWRITE(0, SE); __syncthreads();
  qkt(pA0, pA1, K_lds, qr, r32, hi); PSM(pA0, pA1, mnA, alA, 0);
  SLOAD(SO, KVBLK); if constexpr (SDEPTH == 2) { if (2 < NT) SLOAD(SE, 2 * KVBLK); }
  SWAIT(); SWRITE(1, SO); __syncthreads();
  for (int j = 1; j + 1 < NT; j += 2) {
    SBAR(); qkt(pB0, pB1, K_lds + SHM_K, qr, r32, hi);
    finishSM(pA0, pA1, alA, l_reg, pa0, pa1, pa2, pa3); SBAR();
    SLOAD(SO, (j + SDEPTH) * KVBLK); SBAR();
    pv_d0(o, vb0, pa0, pa1, pa2, pa3); PSM(pB0, pB1, mnB, alB, j);
    __syncthreads(); SWAIT(); SWRITE(0, SE);
    RESC(alB); __syncthreads();
    SBAR(); qkt(pA0, pA1, K_lds, qr, r32, hi);
    finishSM(pB0, pB1, alB, l_reg, pa0, pa1, pa2, pa3); SBAR();
    if (SDEPTH == 1 || j + 3 < NT) SLOAD(SE, (j + 1 + SDEPTH) * KVBLK); SBAR();
    pv_d0(o, vb0 + SHM_V, pa0, pa1, pa2, pa3); PSM(pA0, pA1, mnA, alA, j + 1);
    __syncthreads(); SWAIT(); SWRITE(1, SO);
    RESC(alA); __syncthreads();
  }
  SBAR(); qkt(pB0, pB1, K_lds + SHM_K, qr, r32, hi);
  finishSM(pA0, pA1, alA, l_reg, pa0, pa1, pa2, pa3); SBAR();
  pv_d0(o, vb0, pa0, pa1, pa2, pa3); PSM(pB0, pB1, mnB, alB, NT - 1);
  __syncthreads(); RESC(alB);
  finishSM(pB0, pB1, alB, l_reg, pa0, pa1, pa2, pa3); SBAR();
  pv_d0(o, vb0 + SHM_V, pa0, pa1, pa2, pa3);
  if (hi == 0) li_l[r32] = l_reg; asm volatile("s_waitcnt lgkmcnt(0)" ::: "memory");
  float rli[16];
#pragma unroll
  for (int r = 0; r < 16; ++r) rli[r] = __builtin_amdgcn_rcpf(li_l[crow(r, hi)]);
  bf16_t* Ow = Ob + (long)(wid * QBLK) * LDO;
#pragma unroll
  for (int r = 0; r < 16; ++r) { const int orow = crow(r, hi);
#pragma unroll
    for (int d0 = 0; d0 < 4; ++d0) Ow[(long)orow * LDO + d0 * 32 + r32] = (bf16_t)(cvtpk(o[d0][r] * rli[r], 0.f) & 0xffffu); }
  __syncthreads();
#undef SLOAD
#undef SWRITE
#undef SWAIT
#undef RESC
#undef PSM
}
#undef KSWZ
#undef SBAR
}

#define GAS __attribute__((address_space(1)))
#define LAS __attribute__((address_space(3)))
typedef unsigned short bf16;
typedef unsigned v4u __attribute__((ext_vector_type(4)));
typedef float f32x4 __attribute__((ext_vector_type(4)));
typedef short bf16x8 __attribute__((ext_vector_type(8)));
typedef GAS unsigned gu32;
typedef GAS unsigned long long gu64;
#define RLX_AGENT __ATOMIC_RELAXED, __HIP_MEMORY_SCOPE_AGENT
#define LDS_WAIT() asm volatile("s_waitcnt lgkmcnt(0)" ::: "memory")
#define VM_WAIT() asm volatile("s_waitcnt vmcnt(0)" ::: "memory")
__device__ __forceinline__ unsigned long long rt() { return __builtin_amdgcn_s_memrealtime(); }
__device__ __forceinline__ unsigned f2bf(float f) { unsigned u = __builtin_bit_cast(unsigned, f); return (u + 0x7fffu + ((u >> 16) & 1u)) >> 16; }
__device__ __forceinline__ unsigned pk2(float lo, float hi) { return f2bf(lo) | (f2bf(hi) << 16); }

#define XB_TMO      128
#define XB_XCNT(j)  (256  + 64 * (j))
#define XB_XSUB(j)  (1280 + 64 * (j))
#define XB_XGEN(j)  (2304 + 64 * (j))
#define XB_TOP      3328
#define XB_TOPGEN   3392
#define XCD_BAR_WORDS 3456
#define XB_SPIN_CAP (1u << 18)

__device__ __forceinline__ unsigned xb_ld(unsigned* p)              { return __hip_atomic_load(p, __ATOMIC_RELAXED, __HIP_MEMORY_SCOPE_AGENT); }
__device__ __forceinline__ unsigned xb_add(unsigned* p, unsigned v) { return __hip_atomic_fetch_add(p, v, __ATOMIC_RELAXED, __HIP_MEMORY_SCOPE_AGENT); }
__device__ __forceinline__ unsigned xb_xcc_id() { return (unsigned)__builtin_amdgcn_s_getreg((3 << 11) | 20) & 0xFu; }
#define XB_SPIN(cond, bar) do { unsigned _sp = 0; while (cond) { __builtin_amdgcn_s_sleep(1); \
    if ((++_sp & 255u) == 0u) { if (xb_ld(&(bar)[XB_TMO])) break; if (_sp > XB_SPIN_CAP) { atomicAdd(&(bar)[XB_TMO], 1u); break; } } } } while (0)

struct XcdBarrier {
    unsigned* bar; unsigned x;
    volatile LAS unsigned* st;
};

__device__ __forceinline__ XcdBarrier xcd_barrier_post(unsigned* bar, volatile LAS unsigned* st) {
    XcdBarrier b; b.bar = bar; b.x = xb_xcc_id(); b.st = st;
    if (threadIdx.x == 0) (void)xb_add(&bar[XB_XCNT(b.x)], 1u);
    return b;
}
__device__ __forceinline__ void xcd_barrier_complete(unsigned* bar, unsigned x, unsigned& nloc, unsigned& nx) {
    const unsigned G = gridDim.x * gridDim.y * gridDim.z;
    unsigned sum, cnt, mine, sp = 0u;
    for (;;) {
        sum = 0u; cnt = 0u; mine = 0u;
#pragma unroll
        for (unsigned j = 0; j < 16; ++j) { const unsigned c = xb_ld(&bar[XB_XCNT(j)]); sum += c; cnt += (c > 0u) ? 1u : 0u; mine = (j == x) ? c : mine; }
        if (sum == G) break;
        __builtin_amdgcn_s_sleep(1);
        if ((++sp & 255u) == 0u) { if (xb_ld(&bar[XB_TMO])) break; if (sp > XB_SPIN_CAP) { atomicAdd(&bar[XB_TMO], 1u); break; } }
    }
    nloc = mine > 0u ? mine : 1u; nx = cnt > 0u ? cnt : 1u;
}

__device__ __forceinline__ void xcd_barrier(const XcdBarrier& b) {
    asm volatile("s_waitcnt vmcnt(0)" ::: "memory");
    __syncthreads();
    if (threadIdx.x == 0) {
        unsigned* bar = b.bar;
        __builtin_amdgcn_s_waitcnt(0);
        unsigned nloc = b.st[0], nx = b.st[1];
        if (nloc == 0u) { xcd_barrier_complete(bar, b.x, nloc, nx); b.st[0] = nloc; b.st[1] = nx; }
        const unsigned old = xb_add(&bar[XB_XSUB(b.x)], 1u);
        const unsigned gen = old / nloc;
        if (old + 1u == (gen + 1u) * nloc) {
            __builtin_amdgcn_fence(__ATOMIC_RELEASE, "agent");
            asm volatile("s_waitcnt vmcnt(0)" ::: "memory");
            const unsigned og = xb_add(&bar[XB_TOP], 1u);
            const unsigned tg = og / nx;
            if (og + 1u == (tg + 1u) * nx) xb_add(&bar[XB_TOPGEN], 1u);
            else XB_SPIN(xb_ld(&bar[XB_TOPGEN]) == tg, bar);
            __builtin_amdgcn_fence(__ATOMIC_ACQUIRE, "agent");
            xb_add(&bar[XB_XGEN(b.x)], 1u);
            asm volatile("s_waitcnt vmcnt(0)" ::: "memory");
        } else {
            XB_SPIN(xb_ld(&bar[XB_XGEN(b.x)]) == gen, bar);
            __builtin_amdgcn_fence(__ATOMIC_ACQUIRE, "agent");
            asm volatile("s_waitcnt vmcnt(0)" ::: "memory");
        }
    }
    __syncthreads();
}

constexpr int NWAVES = 8;
constexpr int SEQ = 8192, DM = 4096, FF = 11008, NGU = 2 * FF, NIN = 9216;
constexpr int QA0 = 0, KA0 = 2048, VA0 = 2560, QB0 = 3072, KB0 = 5120, VB0 = 7168;
constexpr float ALPHA = 1.18920711500272106671f;
constexpr float LN_EPS = 1e-5f, RMS_EPS = 1e-6f;
constexpr size_t MiB = 1u << 20;
constexpr size_t WS_CTL = 0, CTL_ZERO_BYTES = 64 * 1024;
constexpr size_t WS_ROPE = 1 * MiB;
constexpr size_t WS_TB = 1 * MiB + 64 * 1024;
constexpr size_t WS_WGU1 = 2 * MiB, WS_WD1 = 174 * MiB, WS_WIN = 260 * MiB, WS_WOUT = 332 * MiB, WS_WGU2 = 364 * MiB, WS_WD2 = 536 * MiB;
constexpr size_t WS_XB = 622 * MiB;
constexpr size_t WS_ACT = 686 * MiB;
constexpr size_t WS_Y = 858 * MiB;
constexpr size_t WS_H = 986 * MiB;
constexpr size_t WS_HB = 1114 * MiB;
constexpr size_t WS_END = 1178 * MiB;
static_assert(WS_WGU1 + (size_t)NGU * DM * 2 <= WS_WD1 && WS_WD1 + (size_t)DM * FF * 2 <= WS_WIN && WS_WIN + (size_t)NIN * DM * 2 <= WS_WOUT && WS_WOUT + (size_t)DM * DM * 2 <= WS_WGU2 &&
              WS_WGU2 + (size_t)NGU * DM * 2 <= WS_WD2 && WS_WD2 + (size_t)DM * FF * 2 <= WS_XB && WS_XB + (size_t)SEQ * DM * 2 <= WS_ACT && WS_ACT + (size_t)SEQ * FF * 2 <= WS_Y &&
              WS_Y + (size_t)SEQ * DM * 4 <= WS_H && WS_H + (size_t)SEQ * DM * 4 <= WS_HB && WS_HB + (size_t)SEQ * DM * 2 <= WS_END, "d_ws map");
constexpr int CW_BAR = 4096;
constexpr int RING_OFF = 0, RING_BYTES = 131072;
constexpr int P0_SCR_PER_WAVE = 64 * 65 * 4;
constexpr int LDSCTL_OFF = 143360;
constexpr int LDS_BYTES = 147456;
static_assert(NWAVES * P0_SCR_PER_WAVE <= LDSCTL_OFF && att::SHM_ATTN <= RING_BYTES && LDSCTL_OFF + 64 <= LDS_BYTES, "LDS map");

__device__ __forceinline__ float wave_sum(float v) {
#pragma unroll
    for (int o = 1; o < 64; o <<= 1) v += __shfl_xor(v, o);
    return v;
}
template <bool GU>
__device__ __forceinline__ void p0_transpose_item(const float* __restrict__ W, int K, int N, bf16* __restrict__ WT, int half, LAS float* scr, int item, int lane) {
    const int nblk = N / 64, kb = item / nblk, nb = item - kb * nblk, k0 = 64 * kb, n0 = 64 * nb;
    const float* src = W + (size_t)k0 * N + n0 + lane;
#pragma unroll 16
    for (int i = 0; i < 64; ++i) scr[i * 65 + lane] = src[(size_t)i * N];
    LDS_WAIT(); asm volatile("" ::: "memory");
    const int c = lane & 7;
    const int drow0 = GU ? ((n0 >> 7) << 8) + (n0 & 127) + 128 * half : n0;
#pragma unroll
    for (int j = 0; j < 8; ++j) { const int n = (lane >> 3) + 8 * j; const LAS float* s = scr + (8 * c) * 65 + n;
        v4u o; o.x = pk2(s[0 * 65], s[1 * 65]); o.y = pk2(s[2 * 65], s[3 * 65]); o.z = pk2(s[4 * 65], s[5 * 65]); o.w = pk2(s[6 * 65], s[7 * 65]);
        *(GAS v4u*)(WT + (size_t)(drow0 + n) * K + k0 + 8 * c) = o; }
    LDS_WAIT(); asm volatile("" ::: "memory");
}
__device__ __forceinline__ int t5_bucket(int rel) {
    const int nb = 16, max_exact = 8; const int ret = rel > 0 ? nb : 0; const int n = rel < 0 ? -rel : rel;
    int large = max_exact + (int)(log((double)(n < 1 ? 1 : n) / (double)max_exact) / log(1024.0 / (double)max_exact) * (double)(nb - max_exact));
    large = large < nb - 1 ? large : nb - 1;
    return ret + (n < max_exact ? n : large);
}
__device__ __forceinline__ void ln_row(const float* __restrict__ yrow, const float* __restrict__ g, const float* __restrict__ b, float* __restrict__ orow, bf16* __restrict__ obrow, int lane) {
    const GAS f32x4* yr = (const GAS f32x4*)yrow + lane;
    f32x4 v[16]; float s = 0.f;
#pragma unroll
    for (int j = 0; j < 16; ++j) { v[j] = yr[64 * j]; s += (v[j].x + v[j].y) + (v[j].z + v[j].w); }
    const float mean = wave_sum(s) * (1.f / DM); float s2 = 0.f;
#pragma unroll
    for (int j = 0; j < 16; ++j) { v[j] = v[j] - mean; s2 += (v[j].x * v[j].x + v[j].y * v[j].y) + (v[j].z * v[j].z + v[j].w * v[j].w); }
    const float rstd = 1.f / sqrtf(wave_sum(s2) * (1.f / DM) + LN_EPS);
    const GAS f32x4* gr = (const GAS f32x4*)g + lane; const GAS f32x4* br = (const GAS f32x4*)b + lane;
    GAS f32x4* o4 = (GAS f32x4*)orow + lane;
#pragma unroll
    for (int j = 0; j < 16; ++j) { const f32x4 gg = gr[64 * j], bb = br[64 * j]; const f32x4 r = v[j] * rstd * gg + bb; o4[64 * j] = r;
        if (obrow) { GAS unsigned long long* o8 = (GAS unsigned long long*)obrow + lane; o8[64 * j] = (unsigned long long)pk2(r.x, r.y) | ((unsigned long long)pk2(r.z, r.w) << 32); } }
}

#ifndef ATT_MASK
#define ATT_MASK 3
#endif
#define ATT_ON(k) ((ATT_MASK >> (k)) & 1)
struct Args { const float* in[18]; float* out; unsigned char* ws; };
__global__ void __launch_bounds__(NWAVES * 64, 2) fwd_kernel(Args args) {
    extern __shared__ __attribute__((aligned(16))) unsigned char lds[];
    LAS unsigned char* ldsl = (LAS unsigned char*)lds;
    const int tid = threadIdx.x, lane = tid & 63, wave = __builtin_amdgcn_readfirstlane(tid >> 6);
    const int G = gridDim.x, bx = blockIdx.x, vcu = (G % 8 == 0) ? (bx % 8) * (G / 8) + bx / 8 : bx;
    const int gw = vcu * NWAVES + wave, NGW = G * NWAVES;
    unsigned char* ws = args.ws;
    gu32* ctl = (gu32*)(ws + WS_CTL);
    const float* x = args.in[0];
    bf16* Wgu1 = (bf16*)(ws + WS_WGU1); bf16* Wd1 = (bf16*)(ws + WS_WD1); bf16* Win = (bf16*)(ws + WS_WIN); bf16* Wout = (bf16*)(ws + WS_WOUT);
    bf16* Wgu2 = (bf16*)(ws + WS_WGU2); bf16* Wd2 = (bf16*)(ws + WS_WD2);
    bf16* XB = (bf16*)(ws + WS_XB); bf16* ACT = (bf16*)(ws + WS_ACT); bf16* PROJ = ACT; bf16* AO = XB; bf16* HB = (bf16*)(ws + WS_HB);
    float* Y = (float*)(ws + WS_Y); float* H = (float*)(ws + WS_H);
    float* ROPE = (float*)(ws + WS_ROPE); float* TB = (float*)(ws + WS_TB);
    for (int u = tid; u < (LDS_BYTES - LDSCTL_OFF) / 4; u += NWAVES * 64) ((LAS unsigned*)(ldsl + LDSCTL_OFF))[u] = 0u;
    __syncthreads();
    XcdBarrier bar = xcd_barrier_post((unsigned*)(ctl + CW_BAR), (volatile LAS unsigned*)(ldsl + LDSCTL_OFF + 32));

    {
        LAS float* scr = (LAS float*)(ldsl + wave * P0_SCR_PER_WAVE);
        constexpr int I_GU = (DM / 64) * (FF / 64), I_D = (FF / 64) * (DM / 64), I_IN = (DM / 64) * (NIN / 64), I_OUT = (DM / 64) * (DM / 64);
        constexpr int NITEMS = 4 * I_GU + 2 * I_D + I_IN + I_OUT;
        for (int it = gw; it < NITEMS; it += NGW) {
            int r = it;
            if (r < I_GU) { p0_transpose_item<true>(args.in[1], DM, FF, Wgu1, 0, scr, r, lane); continue; } r -= I_GU;
            if (r < I_GU) { p0_transpose_item<true>(args.in[2], DM, FF, Wgu1, 1, scr, r, lane); continue; } r -= I_GU;
            if (r < I_D) { p0_transpose_item<false>(args.in[3], FF, DM, Wd1, 0, scr, r, lane); continue; } r -= I_D;
            if (r < I_IN) { p0_transpose_item<false>(args.in[6], DM, NIN, Win, 0, scr, r, lane); continue; } r -= I_IN;
            if (r < I_OUT) { p0_transpose_item<false>(args.in[10], DM, DM, Wout, 0, scr, r, lane); continue; } r -= I_OUT;
            if (r < I_GU) { p0_transpose_item<true>(args.in[13], DM, FF, Wgu2, 0, scr, r, lane); continue; } r -= I_GU;
            if (r < I_GU) { p0_transpose_item<true>(args.in[14], DM, FF, Wgu2, 1, scr, r, lane); continue; } r -= I_GU;
            p0_transpose_item<false>(args.in[15], FF, DM, Wd2, 0, scr, r, lane);
        }
        const size_t n8 = (size_t)SEQ * DM / 8;
        for (size_t i = (size_t)gw * 64 + lane; i < n8; i += (size_t)NGW * 64) {
            const f32x4 a = *(const GAS f32x4*)(x + i * 8), b = *(const GAS f32x4*)(x + i * 8 + 4);
            v4u o; o.x = pk2(a.x, a.y); o.y = pk2(a.z, a.w); o.z = pk2(b.x, b.y); o.w = pk2(b.z, b.w);
            *(GAS v4u*)(XB + i * 8) = o; }
        for (int e = bx * (NWAVES * 64) + tid; e < 128 * 32; e += G * NWAVES * 64) {
            const int pos = e >> 5, i = e & 31; const float inv = powf(10000.0f, -(float)(2 * i) / 64.0f); const float ang = (float)pos * inv;
            ROPE[2 * e] = cosf(ang); ROPE[2 * e + 1] = sinf(ang); }
        for (int e = bx * (NWAVES * 64) + tid; e < 16 * att::TBN; e += G * NWAVES * 64) {
            const int h = e / att::TBN, d = e % att::TBN - att::TB0; const int ad = d < 0 ? -d : d;
            const int cnt = (ad <= 64 ? 1 : 0) + (((ad & 3) == 0 && ad <= 256) ? 1 : 0) + (((ad & 15) == 0 && ad <= 1024) ? 1 : 0);
            float v = -INFINITY;
            if (cnt > 0) v = (args.in[9][t5_bucket(d) * 16 + h] + logf((float)cnt)) * 1.4426950408889634f;
            TB[e] = v; }
    }
    xcd_barrier(bar);

    { pg8::Gemm g{XB, Wgu1, SEQ, NGU, DM}; pg8::StaticOrder S; S.init(SEQ, NGU, G, bx);
      pg8::EpiSwiGLU E{ACT, FF};
      pg8::gemm_phase<pg8::EpiSwiGLU, pg8::StaticOrder, true, true>(ldsl + RING_OFF, g, S, E); }
    xcd_barrier(bar);
    { pg8::Gemm g{ACT, Wd1, SEQ, DM, FF}; pg8::StaticOrder S; S.init(SEQ, DM, G, bx);
      pg8::EpiRes E{x, Y, DM, ALPHA, 0.5f};
      pg8::gemm_phase<pg8::EpiRes, pg8::StaticOrder, true, true>(ldsl + RING_OFF, g, S, E); }
    xcd_barrier(bar);
    for (int m = gw; m < SEQ; m += NGW) ln_row(Y + (size_t)m * DM, args.in[4], args.in[5], H + (size_t)m * DM, HB + (size_t)m * DM, lane);
    xcd_barrier(bar);
    { pg8::Gemm g{HB, Win, SEQ, NIN, DM}; pg8::StaticOrder S; S.init(SEQ, NIN, G, bx);
      pg8::EpiBf16 E{PROJ, NIN};
      pg8::gemm_phase<pg8::EpiBf16, pg8::StaticOrder, true, true>(ldsl + RING_OFF, g, S, E); }
    xcd_barrier(bar);
    {
        const float* qg = args.in[7]; const float* kg = args.in[8];
        const float qg0 = qg[2 * lane], qg1 = qg[2 * lane + 1], kg0 = kg[2 * lane], kg1 = kg[2 * lane + 1];
        for (int t = gw; t < SEQ; t += NGW) {
            const int pos = lane < 32 ? (t >> 6) : (t & 63), fi = lane & 31;
            const float c = ROPE[2 * (pos * 32 + fi)], s = ROPE[2 * (pos * 32 + fi) + 1];
            GAS unsigned* row = (GAS unsigned*)(PROJ + (size_t)t * NIN) + lane;
            unsigned w[20];
#pragma unroll
            for (int hh = 0; hh < 20; ++hh) w[hh] = row[64 * hh];
#pragma unroll
            for (int hh = 0; hh < 20; ++hh) {
                const float x1 = __uint_as_float(w[hh] << 16), x2 = __uint_as_float(w[hh] & 0xffff0000u);
                const float ss = wave_sum(x1 * x1 + x2 * x2);
                const float rs = 1.0f / sqrtf(ss * (1.0f / 128.0f) + RMS_EPS);
                const float n1 = x1 * rs * (hh < 16 ? qg0 : kg0), n2 = x2 * rs * (hh < 16 ? qg1 : kg1);
                row[64 * hh] = pk2(n1 * c - n2 * s, n1 * s + n2 * c);
            }
        }
    }
    xcd_barrier(bar);
#if ATT_ON(0)
    for (int u = vcu; u < 512; u += G) {
        const int head = u >> 5, qblk = u & 31, P0 = qblk * 256, kvh = head >> 2;
        att::attn_body<false, 2>(PROJ + (size_t)P0 * NIN + QA0 + head * 128, PROJ + KA0 + kvh * 128, PROJ + VA0 + kvh * 128, AO + (size_t)P0 * DM + head * 128, SEQ / 64, 0, (char*)lds);
    }
#endif
#if ATT_ON(1)
    for (int u = vcu; u < 512; u += G) {
        const int head = u >> 5, qblk = u & 31, P0 = qblk * 256;
        for (int e = tid; e < att::TBN; e += NWAVES * 64) ((LAS float*)(ldsl + att::OFF_TB))[e] = TB[head * att::TBN + e];
        const int ks = P0 - 1024 < 0 ? 0 : P0 - 1024, ke = P0 + 1280 > SEQ ? SEQ : P0 + 1280;
        att::attn_body<true, 1>(PROJ + (size_t)P0 * NIN + QB0 + head * 128, PROJ + (size_t)ks * NIN + KB0 + head * 128, PROJ + (size_t)ks * NIN + VB0 + head * 128,
                             AO + (size_t)P0 * DM + 2048 + head * 128, (ke - ks) / 64, ks - P0, (char*)lds);
    }
#endif
    xcd_barrier(bar);
    { pg8::Gemm g{AO, Wout, SEQ, DM, DM}; pg8::StaticOrder S; S.init(SEQ, DM, G, bx);
      pg8::EpiRes E{H, Y, DM, ALPHA, 1.0f};
      pg8::gemm_phase<pg8::EpiRes, pg8::StaticOrder, true, true>(ldsl + RING_OFF, g, S, E); }
    xcd_barrier(bar);
    for (int m = gw; m < SEQ; m += NGW) ln_row(Y + (size_t)m * DM, args.in[11], args.in[12], H + (size_t)m * DM, HB + (size_t)m * DM, lane);
    xcd_barrier(bar);
    { pg8::Gemm g{HB, Wgu2, SEQ, NGU, DM}; pg8::StaticOrder S; S.init(SEQ, NGU, G, bx);
      pg8::EpiSwiGLU E{ACT, FF};
      pg8::gemm_phase<pg8::EpiSwiGLU, pg8::StaticOrder, true, true>(ldsl + RING_OFF, g, S, E); }
    xcd_barrier(bar);
    { pg8::Gemm g{ACT, Wd2, SEQ, DM, FF}; pg8::StaticOrder S; S.init(SEQ, DM, G, bx);
      pg8::EpiRes E{H, Y, DM, ALPHA, 0.5f};
      pg8::gemm_phase<pg8::EpiRes, pg8::StaticOrder, true, true>(ldsl + RING_OFF, g, S, E); }
    xcd_barrier(bar);
    for (int m = gw; m < SEQ; m += NGW) ln_row(Y + (size_t)m * DM, args.in[16], args.in[17], args.out + (size_t)m * DM, nullptr, lane);
}

extern "C" void kernel_launch(void* const* d_in, const int* in_sizes, int n_in, void* d_out, int out_size, void* d_ws, size_t ws_size, hipStream_t stream) {
    static int grid = 0;
    if (grid == 0) {
        if (n_in != 18 || in_sizes[0] != SEQ * DM || out_size != SEQ * DM || ws_size < WS_END) {
            fprintf(stderr, "kernel_launch: built for 18 inputs, x/out of %d floats, >= %zu bytes of workspace; got n_in %d, in0 %d, out %d, ws %zu; nothing launched\n", SEQ * DM, (size_t)WS_END, n_in, n_in > 0 ? in_sizes[0] : -1, out_size, ws_size);
            grid = -1; return; }
        int dev = 0, cus = 0, per_cu = 0;
        if (hipGetDevice(&dev) != hipSuccess || hipDeviceGetAttribute(&cus, hipDeviceAttributeMultiprocessorCount, dev) != hipSuccess) { fprintf(stderr, "kernel_launch: device query failed\n"); grid = -1; return; }
        if (hipFuncSetAttribute((const void*)fwd_kernel, hipFuncAttributeMaxDynamicSharedMemorySize, LDS_BYTES) != hipSuccess) { fprintf(stderr, "kernel_launch: hipFuncSetAttribute failed\n"); grid = -1; return; }
        if (hipOccupancyMaxActiveBlocksPerMultiprocessor(&per_cu, (const void*)fwd_kernel, NWAVES * 64, LDS_BYTES) != hipSuccess || per_cu < 1)
            fprintf(stderr, "kernel_launch: note: occupancy query reports %d workgroups per CU\n", per_cu);
        (void)hipGetLastError();
        grid = cus;
    }
    if (grid < 0) return;
    if (hipMemsetAsync((char*)d_ws + WS_CTL, 0, CTL_ZERO_BYTES, stream) != hipSuccess) { fprintf(stderr, "kernel_launch: hipMemsetAsync failed\n"); return; }
    Args a{};
    for (int i = 0; i < 18; ++i) a.in[i] = (const float*)d_in[i];
    a.out = (float*)d_out; a.ws = (unsigned char*)d_ws;
    hipLaunchKernelGGL(fwd_kernel, dim3(grid), dim3(NWAVES * 64), LDS_BYTES, stream, a);
    const hipError_t le = hipPeekAtLastError();
    if (le != hipSuccess) fprintf(stderr, "kernel_launch: launch failed: %s\n", hipGetErrorName(le));
}
```

```cpp
#include <hip/hip_runtime.h>
#ifndef PADK
#define PADK 0
#endif
#ifndef PADF
#define PADF 0
#endif
#include <hip/hip_bf16.h>
#include <cstdio>
#include <cstdint>
#include <cmath>
namespace pg8 {
#define PG8_LAS __attribute__((address_space(3)))
typedef unsigned short bf16_t;
typedef short bf16x8 __attribute__((ext_vector_type(8)));
typedef float f32x4 __attribute__((ext_vector_type(4)));
typedef unsigned u32x4 __attribute__((ext_vector_type(4)));
constexpr int BM = 256, BK = 64, HALF = 128, HTB = HALF * BK * 2  , STAGE_BYTES = 8 * HTB, NXCD = 8, WGM = 8;

__host__ __device__ __forceinline__ int lds_byte(int r, int c) { const int st = (r >> 4) * 2 + (c >> 5), rr = r & 15, cc = c & 31, ob = rr * 64 + cc * 2; return st * 1024 + (ob ^ (((ob >> 9) & 1) << 5)); }
__host__ __device__ __forceinline__ void stage_rc(int b, int& R, int& C) { const int st = b / 1024, sb = b % 1024, swz = sb ^ (((sb >> 9) & 1) << 5); R = (st >> 1) * 16 + swz / 64; C = (st & 1) * 32 + (swz % 64) / 2; }
__host__ __device__ __forceinline__ int perm32(int rho) { const int n = rho >> 4, i = rho & 15; return 8 * (i >> 2) + 4 * n + (i & 3); }

struct Unit { int pm, pn; };
struct Gemm { const bf16_t* A; const bf16_t* Bt; int M, N, K; };
__host__ __device__ __forceinline__ size_t blk_off(int r, int k, int K) { return ((size_t)(r >> 8) * (K >> 6) + (k >> 6)) * (size_t)(256 * 64) + (size_t)(r & 255) * 64 + (k & 63); }

struct StaticOrder {
    int nM, nN, nwg, G, c;
    __host__ __device__ void init(int M, int N, int G_, int c_) { nM = M / BM; nN = N / BM; nwg = nM * nN; G = G_; c = c_; }
    __host__ __device__ bool next(int i, Unit& u) const {
        const long L = (long)i * G + c; if (L >= nwg) return false;
        int wgid = (int)L; { const int q = nwg / NXCD, r = nwg % NXCD, xcd = wgid % NXCD, off = wgid / NXCD; wgid = (xcd < r ? xcd * (q + 1) : r * (q + 1) + (xcd - r) * q) + off; }
        const int nig = WGM * nN, gid = wgid / nig, fm = gid * WGM, gsz = (nM - fm) < WGM ? (nM - fm) : WGM;
        u.pm = fm + ((wgid % nig) % gsz); u.pn = (wgid % nig) / gsz; return true;
    }
    __device__ __forceinline__ void a_ready(const Unit&) const {}
    __device__ __forceinline__ void done(const Unit&) const {}
};

typedef float f32x2 __attribute__((ext_vector_type(2)));
__device__ __forceinline__ unsigned cvt_pk_bf16(float lo, float hi) { unsigned r; asm volatile("v_cvt_pk_bf16_f32 %0, %1, %2" : "=v"(r) : "v"(lo), "v"(hi)); return r; }
struct EpiBf16 {
    static constexpr bool PERM = true, AFTER_DRAIN = false;
    bf16_t* O; int ldc;
    __device__ __forceinline__ void operator()(const f32x4 (&acc)[2][2][4][2], const Unit& u, int wr, int wc, int fr, int fq) const {
        const int row0 = u.pm * BM + wr * 64 + fr, col0 = u.pn * BM + wc * 32 + 8 * fq;
#pragma unroll
        for (int ai = 0; ai < 2; ++ai)
#pragma unroll
            for (int m = 0; m < 4; ++m) { bf16_t* rowp = O + (size_t)(row0 + ai * HALF + m * 16) * ldc + col0;
#pragma unroll
                for (int bj = 0; bj < 2; ++bj) { const f32x4 v0 = acc[ai][bj][m][0], v1 = acc[ai][bj][m][1];
                    u32x4 w; w.x = cvt_pk_bf16(v0[0], v0[1]); w.y = cvt_pk_bf16(v0[2], v0[3]); w.z = cvt_pk_bf16(v1[0], v1[1]); w.w = cvt_pk_bf16(v1[2], v1[3]);
                    *(u32x4*)(rowp + bj * HALF) = w; } }
    }
};
struct EpiBf16Heads {
    static constexpr bool PERM = true, AFTER_DRAIN = false;
    bf16_t* O; int rows;
    __device__ __forceinline__ void operator()(const f32x4 (&acc)[2][2][4][2], const Unit& u, int wr, int wc, int fr, int fq) const {
        const int row0 = u.pm * BM + wr * 64 + fr, col0 = wc * 32 + 8 * fq;
#pragma unroll
        for (int bj = 0; bj < 2; ++bj) { bf16_t* hb = O + (size_t)(2 * u.pn + bj) * rows * 128 + col0;
#pragma unroll
            for (int ai = 0; ai < 2; ++ai)
#pragma unroll
                for (int m = 0; m < 4; ++m) { const f32x4 v0 = acc[ai][bj][m][0], v1 = acc[ai][bj][m][1];
                    u32x4 w; w.x = cvt_pk_bf16(v0[0], v0[1]); w.y = cvt_pk_bf16(v0[2], v0[3]); w.z = cvt_pk_bf16(v1[0], v1[1]); w.w = cvt_pk_bf16(v1[2], v1[3]);
                    *(u32x4*)(hb + (size_t)(row0 + ai * HALF + m * 16) * 128) = w; } }
    }
};
__device__ __forceinline__ float silu_mul(float g, float u) { return g * __builtin_amdgcn_rcpf(1.0f + __builtin_amdgcn_exp2f(g * -1.4426950408889634f)) * u; }
struct EpiSwiGLU {
    static constexpr bool PERM = true, AFTER_DRAIN = false;
    bf16_t* O; int ldc; float sc;
    __device__ __forceinline__ void operator()(const f32x4 (&acc)[2][2][4][2], const Unit& u, int wr, int wc, int fr, int fq) const {
        const int row0 = u.pm * BM + wr * 64 + fr, col0 = u.pn * HALF + wc * 32 + 8 * fq;
#pragma unroll
        for (int ai = 0; ai < 2; ++ai)
#pragma unroll
            for (int m = 0; m < 4; ++m) { bf16_t* rowp = O + blk_off(row0 + ai * HALF + m * 16, col0, ldc);
                const f32x4 g0 = acc[ai][0][m][0] * sc, g1 = acc[ai][0][m][1] * sc, u0 = acc[ai][1][m][0] * sc, u1 = acc[ai][1][m][1] * sc;
                u32x4 w; w.x = cvt_pk_bf16(silu_mul(g0[0], u0[0]), silu_mul(g0[1], u0[1])); w.y = cvt_pk_bf16(silu_mul(g0[2], u0[2]), silu_mul(g0[3], u0[3]));
                w.z = cvt_pk_bf16(silu_mul(g1[0], u1[0]), silu_mul(g1[1], u1[1])); w.w = cvt_pk_bf16(silu_mul(g1[2], u1[2]), silu_mul(g1[3], u1[3]));
                *(u32x4*)rowp = w; }
    }
};
struct EpiRes {
    static constexpr bool PERM = false, AFTER_DRAIN = false;
    const float* R; float* Y; int ldc; float ra, sa;
    __device__ __forceinline__ void operator()(const f32x4 (&acc)[2][2][4][2], const Unit& u, int wr, int wc, int fr, int fq) const {
        const int row0 = u.pm * BM + wr * 64 + fr, col0 = u.pn * BM + wc * 32 + 4 * fq;
#pragma unroll
        for (int ai = 0; ai < 2; ++ai)
#pragma unroll
            for (int m = 0; m < 4; ++m) { const size_t off = (size_t)(row0 + ai * HALF + m * 16) * ldc + col0;
                f32x4 rv[2][2];
#pragma unroll
                for (int bj = 0; bj < 2; ++bj)
#pragma unroll
                    for (int n = 0; n < 2; ++n) rv[bj][n] = *(const f32x4*)(R + off + bj * HALF + n * 16);
#pragma unroll
                for (int bj = 0; bj < 2; ++bj)
#pragma unroll
                    for (int n = 0; n < 2; ++n) *(f32x4*)(Y + off + bj * HALF + n * 16) = rv[bj][n] * ra + acc[ai][bj][m][n] * sa;
                if (m & 1) asm volatile("" ::: "memory"); }
    }
};
constexpr float LNF_EPS = 1e-5f, LNF_INVD = 1.0f / 4096.0f;
constexpr int LNF_ROWS = 8192;
__device__ __forceinline__ void row_mu_rs(const float* st, int row, float& mu, float& rs) {
    const float s = st[row], q = st[LNF_ROWS + row]; mu = s * LNF_INVD; const float var = q * LNF_INVD - mu * mu; rs = __builtin_amdgcn_rsqf(fmaxf(var, 0.f) + LNF_EPS);
}
template <bool NORM, bool OUTB, bool STAT, int SA2  > struct EpiResN {
    static constexpr bool PERM = true, AFTER_DRAIN = false;
    static constexpr int ldc = 4096; static constexpr float ra = 1.18920711500272106671f  , sa = 0.5f * SA2;
    const float* R; float* Y; bf16_t* YB;
    const float* pst; const float* g; const float* b; float* ost;
    __device__ __forceinline__ void operator()(const f32x4 (&acc)[2][2][4][2], const Unit& u, int wr, int wc, int fr, int fq) const {
        const int row0 = u.pm * BM + wr * 64 + fr, col0 = u.pn * BM + wc * 32 + 8 * fq;
        f32x4 gv[2][2], bv[2][2]; float ssel = 0.f, qsel = 0.f; float mus[2][4], rss[2][4];
        if constexpr (NORM) {
#pragma unroll
            for (int bj = 0; bj < 2; ++bj)
#pragma unroll
                for (int n = 0; n < 2; ++n) { gv[bj][n] = *(const f32x4*)(g + col0 + bj * HALF + 4 * n); bv[bj][n] = *(const f32x4*)(b + col0 + bj * HALF + 4 * n); }
#pragma unroll
            for (int ai = 0; ai < 2; ++ai)
#pragma unroll
                for (int m = 0; m < 4; ++m) row_mu_rs(pst, row0 + ai * HALF + m * 16, mus[ai][m], rss[ai][m]);
        }
#pragma unroll
        for (int ai = 0; ai < 2; ++ai)
#pragma unroll
            for (int m = 0; m < 4; ++m) { const int row = row0 + ai * HALF + m * 16; const size_t off = (size_t)row * ldc + col0;
                float mu = 0.f, rs = 1.f; if constexpr (NORM) { mu = mus[ai][m]; rs = rss[ai][m]; }
                f32x4 rv[2][2];
#pragma unroll
                for (int bj = 0; bj < 2; ++bj)
#pragma unroll
                    for (int n = 0; n < 2; ++n) rv[bj][n] = *(const f32x4*)(R + off + bj * HALF + 4 * n);
                float s = 0.f, q = 0.f;
#pragma unroll
                for (int bj = 0; bj < 2; ++bj) { f32x4 y[2];
#pragma unroll
                    for (int n = 0; n < 2; ++n) { f32x4 r = rv[bj][n]; if constexpr (NORM) r = (r - mu) * rs * gv[bj][n] + bv[bj][n];
                        y[n] = r * ra + acc[ai][bj][m][n] * sa; *(f32x4*)(Y + off + bj * HALF + 4 * n) = y[n];
                        if constexpr (STAT) { s += (y[n][0] + y[n][1]) + (y[n][2] + y[n][3]); q += (y[n][0] * y[n][0] + y[n][1] * y[n][1]) + (y[n][2] * y[n][2] + y[n][3] * y[n][3]); } }
                    if constexpr (OUTB) { u32x4 w; w.x = cvt_pk_bf16(y[0][0], y[0][1]); w.y = cvt_pk_bf16(y[0][2], y[0][3]); w.z = cvt_pk_bf16(y[1][0], y[1][1]); w.w = cvt_pk_bf16(y[1][2], y[1][3]);
                        *(u32x4*)(YB + blk_off(row, col0 + bj * HALF, ldc)) = w; } }
                if constexpr (STAT) { s += __shfl_xor(s, 16); s += __shfl_xor(s, 32); q += __shfl_xor(q, 16); q += __shfl_xor(q, 32);
                    if (fq == m) { ssel = s; qsel = q; }
                    if (m == 3) { const int arow = row0 - fr + ai * HALF + fq * 16 + fr; unsafeAtomicAdd(ost + arow, ssel); unsafeAtomicAdd(ost + LNF_ROWS + arow, qsel); } }
                if (m & 1) asm volatile("" ::: "memory"); }
    }
};
struct EpiBf16HeadsN {
    static constexpr bool PERM = true, AFTER_DRAIN = false;
    bf16_t* O; int rows; const float* st; const float* c1; const float* c2;
    __device__ __forceinline__ void operator()(const f32x4 (&acc)[2][2][4][2], const Unit& u, int wr, int wc, int fr, int fq) const {
        const int row0 = u.pm * BM + wr * 64 + fr, col0 = wc * 32 + 8 * fq, colt = u.pn * BM + col0;
        f32x4 c1v[2][2], c2v[2][2];
#pragma unroll
        for (int bj = 0; bj < 2; ++bj)
#pragma unroll
            for (int n = 0; n < 2; ++n) { c1v[bj][n] = *(const f32x4*)(c1 + colt + bj * HALF + 4 * n); c2v[bj][n] = *(const f32x4*)(c2 + colt + bj * HALF + 4 * n); }
        float mus[2][4], rss[2][4];
#pragma unroll
        for (int ai = 0; ai < 2; ++ai)
#pragma unroll
            for (int m = 0; m < 4; ++m) row_mu_rs(st, row0 + ai * HALF + m * 16, mus[ai][m], rss[ai][m]);
#pragma unroll
        for (int ai = 0; ai < 2; ++ai)
#pragma unroll
            for (int m = 0; m < 4; ++m) { const int row = row0 + ai * HALF + m * 16; const float mu = mus[ai][m], rs = rss[ai][m];
#pragma unroll
                for (int bj = 0; bj < 2; ++bj) { const f32x4 v0 = (acc[ai][bj][m][0] - c1v[bj][0] * mu) * rs + c2v[bj][0], v1 = (acc[ai][bj][m][1] - c1v[bj][1] * mu) * rs + c2v[bj][1];
                    u32x4 w; w.x = cvt_pk_bf16(v0[0], v0[1]); w.y = cvt_pk_bf16(v0[2], v0[3]); w.z = cvt_pk_bf16(v1[0], v1[1]); w.w = cvt_pk_bf16(v1[2], v1[3]);
                    *(u32x4*)(O + ((size_t)(2 * u.pn + bj) * rows + row) * 128 + col0) = w; } }
    }
};
struct EpiSwiGLUN {
    static constexpr bool PERM = true, AFTER_DRAIN = false;
    bf16_t* O; int ldc; const float* st; const float* c1; const float* c2;
    __device__ __forceinline__ void operator()(const f32x4 (&acc)[2][2][4][2], const Unit& u, int wr, int wc, int fr, int fq) const {
        const int row0 = u.pm * BM + wr * 64 + fr, col0 = u.pn * HALF + wc * 32 + 8 * fq, colt = u.pn * BM + wc * 32 + 8 * fq;
        f32x4 c1v[2][2], c2v[2][2];
#pragma unroll
        for (int bj = 0; bj < 2; ++bj)
#pragma unroll
            for (int n = 0; n < 2; ++n) { c1v[bj][n] = *(const f32x4*)(c1 + colt + bj * HALF + 4 * n); c2v[bj][n] = *(const f32x4*)(c2 + colt + bj * HALF + 4 * n); }
        float mus[2][4], rss[2][4];
#pragma unroll
        for (int ai = 0; ai < 2; ++ai)
#pragma unroll
            for (int m = 0; m < 4; ++m) row_mu_rs(st, row0 + ai * HALF + m * 16, mus[ai][m], rss[ai][m]);
#pragma unroll
        for (int ai = 0; ai < 2; ++ai)
#pragma unroll
            for (int m = 0; m < 4; ++m) { const int row = row0 + ai * HALF + m * 16; const float mu = mus[ai][m], rs = rss[ai][m];
                const f32x4 g0 = (acc[ai][0][m][0] - c1v[0][0] * mu) * rs + c2v[0][0], g1 = (acc[ai][0][m][1] - c1v[0][1] * mu) * rs + c2v[0][1];
                const f32x4 u0 = (acc[ai][1][m][0] - c1v[1][0] * mu) * rs + c2v[1][0], u1 = (acc[ai][1][m][1] - c1v[1][1] * mu) * rs + c2v[1][1];
                u32x4 w; w.x = cvt_pk_bf16(silu_mul(g0[0], u0[0]), silu_mul(g0[1], u0[1])); w.y = cvt_pk_bf16(silu_mul(g0[2], u0[2]), silu_mul(g0[3], u0[3]));
                w.z = cvt_pk_bf16(silu_mul(g1[0], u1[0]), silu_mul(g1[1], u1[1])); w.w = cvt_pk_bf16(silu_mul(g1[2], u1[2]), silu_mul(g1[3], u1[3]));
                *(u32x4*)(O + blk_off(row, col0, ldc)) = w; }
    }
};

template <class Epi, class Sched, bool ALIGN_EPI = false, bool SP2 = false, int KREP = 1  , bool KBLK = false  >
__device__ __forceinline__ void gemm_phase(PG8_LAS unsigned char* lds, const Gemm g, const Sched& S, const Epi& E) {
    int tid_ = threadIdx.x; asm volatile("" : "+v"(tid_));
    const int tid = tid_, wid = __builtin_amdgcn_readfirstlane(tid >> 6), lane = tid & 63, wr = wid >> 2, wc = wid & 3, fr = lane & 15, fq = lane >> 4;
    const int K = g.K, nt = K / BK;
    unsigned voffA[2], voffB[2];
#pragma unroll
    for (int i = 0; i < 2; ++i) { int R, C; stage_rc(tid * 16 + i * 8192, R, C); const int Rb = Epi::PERM ? ((R & ~31) + perm32(R & 31)) : R;
        voffA[i] = (unsigned)(R * BK + C) * 2u; voffB[i] = (unsigned)(Rb * BK + C) * 2u; }
    const size_t kstep = (size_t)(BM * BK * 2);
    const size_t hstepA = (size_t)HALF * BK * 2, hstepB = hstepA;
    const size_t tstepA = (size_t)nt * kstep, tstepB = tstepA;
    const unsigned ldsw = (unsigned)wid * 1024u;
    const int aoff = lds_byte(wr * 64 + fr, fq * 8), boff = lds_byte(wc * 32 + fr, fq * 8);
#define PG8_SA(b, h) (((b) * 2 + (h)) * HTB)
#define PG8_SB(b, h) ((4 + (b) * 2 + (h)) * HTB)
#define PG8_STAGE(bufoff, gbase, voff) do { _Pragma("unroll") for (int _i = 0; _i < 2; ++_i) \
        __builtin_amdgcn_global_load_lds((const unsigned*)((const char*)(gbase) + (voff)[_i]), (PG8_LAS unsigned*)(lds + (bufoff) + ldsw + _i * 8192), 16, 0, 0); } while (0)
#define PG8_LDA(dst, b, h) do { _Pragma("unroll") for (int m = 0; m < 4; ++m) _Pragma("unroll") for (int k = 0; k < 2; ++k) dst[m][k] = *(const PG8_LAS bf16x8*)(lds + PG8_SA(b, h) + aoff + m * 2048 + k * 1024); } while (0)
#define PG8_LDB(dst, b, h) do { _Pragma("unroll") for (int n = 0; n < 2; ++n) _Pragma("unroll") for (int k = 0; k < 2; ++k) dst[n][k] = *(const PG8_LAS bf16x8*)(lds + PG8_SB(b, h) + boff + n * 2048 + k * 1024); } while (0)
#define PG8_MMA(ai, bj, At, Bt) do { _Pragma("unroll") for (int m = 0; m < 4; ++m) _Pragma("unroll") for (int n = 0; n < 2; ++n) _Pragma("unroll") for (int k = 0; k < 2; ++k) \
        acc[ai][bj][m][n] = __builtin_amdgcn_mfma_f32_16x16x32_bf16(Bt[n][k], At[m][k], acc[ai][bj][m][n], 0, 0, 0); } while (0)
#define PG8_WAIT_V(n) asm volatile("s_waitcnt vmcnt(" #n ")" ::: "memory")
#define PG8_WAIT_L(n) asm volatile("s_waitcnt lgkmcnt(" #n ")" ::: "memory")
#define PG8_BAR __builtin_amdgcn_s_barrier()
#define PG8_SCHED __builtin_amdgcn_sched_barrier(0)
    Unit cur, nxt; int ui = 0;
    if (!S.next(0, cur)) return;
    f32x4 acc[2][2][4][2];
#pragma unroll
    for (int a = 0; a < 2; ++a)
#pragma unroll
        for (int b = 0; b < 2; ++b)
#pragma unroll
            for (int m = 0; m < 4; ++m)
#pragma unroll
                for (int n = 0; n < 2; ++n) acc[a][b][m][n] = (f32x4){0.f, 0.f, 0.f, 0.f};
    bf16x8 At[4][2], B0[2][2], B1[2][2];
    const char* cA = (const char*)g.A + (size_t)cur.pm * tstepA; const char* cB = (const char*)g.Bt + (size_t)cur.pn * tstepB;
    S.a_ready(cur);
    if constexpr (SP2) {
        PG8_STAGE(PG8_SB(0, 0), cB, voffB); PG8_STAGE(PG8_SB(0, 1), cB + hstepB, voffB); PG8_STAGE(PG8_SA(0, 0), cA, voffA); PG8_STAGE(PG8_SA(0, 1), cA + hstepA, voffA);
        if (wr == 1) PG8_BAR;
        PG8_WAIT_V(2); PG8_BAR;
        PG8_STAGE(PG8_SB(1, 0), cB + kstep, voffB); PG8_STAGE(PG8_SA(1, 0), cA + kstep, voffA); PG8_STAGE(PG8_SB(1, 1), cB + hstepB + kstep, voffB);
        PG8_WAIT_V(6); PG8_BAR;
    } else {
        PG8_STAGE(PG8_SB(0, 0), cB, voffB); PG8_STAGE(PG8_SA(0, 0), cA, voffA); PG8_STAGE(PG8_SB(0, 1), cB + hstepB, voffB); PG8_STAGE(PG8_SA(0, 1), cA + hstepA, voffA);
        if (wr == 1) PG8_BAR;
        PG8_WAIT_V(4); PG8_BAR;
        PG8_STAGE(PG8_SB(1, 0), cB + kstep, voffB); PG8_STAGE(PG8_SA(1, 0), cA + kstep, voffA); PG8_STAGE(PG8_SB(1, 1), cB + hstepB + kstep, voffB);
        PG8_WAIT_V(6); PG8_BAR;
    }
    for (;;) {
        const bool has_next = S.next(ui + 1, nxt);
        const char* nA = has_next ? (const char*)g.A + (size_t)nxt.pm * tstepA : cA; const char* nB = has_next ? (const char*)g.Bt + (size_t)nxt.pn * tstepB : cB;
        for (int tt = 0; tt < nt * KREP; tt += 2) {
            const bool last = (tt == nt * KREP - 2);
            const int t = (KREP == 1) ? tt : (KBLK ? 4 * (tt / 8) + (tt % 4) : tt % nt), t2 = (KREP == 1) ? tt + 2 : (KBLK ? 4 * (((tt + 2) % (2 * nt)) / 8) + ((tt + 2) % 4) : (tt + 2) % nt);
            const char* a1 = cA + (size_t)(t + 1) * kstep;
            const char* a2 = last ? nA : cA + (size_t)t2 * kstep; const char* b2 = last ? nB : cB + (size_t)t2 * kstep;
            const char* a3 = a2 + kstep; const char* b3 = b2 + kstep;
            if (last && has_next) S.a_ready(nxt);
            if constexpr (SP2) {
            PG8_LDB(B0, 0, 0); PG8_LDB(B1, 0, 1); PG8_SCHED; PG8_LDA(At, 0, 0); PG8_STAGE(PG8_SA(1, 1), a1 + hstepA, voffA);
            PG8_WAIT_V(8); PG8_WAIT_L(0); __builtin_amdgcn_s_setprio(1); PG8_BAR; PG8_MMA(0, 0, At, B0); PG8_MMA(0, 1, At, B1); __builtin_amdgcn_s_setprio(0); PG8_BAR; PG8_SCHED;
            PG8_LDA(At, 0, 1); PG8_STAGE(PG8_SB(0, 0), b2, voffB); PG8_STAGE(PG8_SB(0, 1), b2 + hstepB, voffB); PG8_STAGE(PG8_SA(0, 0), a2, voffA);
            PG8_WAIT_V(8); PG8_WAIT_L(0); __builtin_amdgcn_s_setprio(1); PG8_BAR; PG8_MMA(1, 0, At, B0); PG8_MMA(1, 1, At, B1); __builtin_amdgcn_s_setprio(0); PG8_BAR; PG8_SCHED;
            PG8_LDB(B0, 1, 0); PG8_LDB(B1, 1, 1); PG8_SCHED; PG8_LDA(At, 1, 0); PG8_STAGE(PG8_SA(0, 1), a2 + hstepA, voffA);
            PG8_WAIT_V(8); PG8_WAIT_L(0); __builtin_amdgcn_s_setprio(1); PG8_BAR; PG8_MMA(0, 0, At, B0); PG8_MMA(0, 1, At, B1); __builtin_amdgcn_s_setprio(0); PG8_BAR; PG8_SCHED;
            PG8_LDA(At, 1, 1); PG8_STAGE(PG8_SB(1, 0), b3, voffB); PG8_STAGE(PG8_SB(1, 1), b3 + hstepB, voffB); PG8_STAGE(PG8_SA(1, 0), a3, voffA);
            PG8_WAIT_V(8); PG8_WAIT_L(0); __builtin_amdgcn_s_setprio(1); PG8_BAR; PG8_MMA(1, 0, At, B0); PG8_MMA(1, 1, At, B1); __builtin_amdgcn_s_setprio(0); PG8_BAR; PG8_SCHED;
            } else {
            PG8_LDB(B0, 0, 0); PG8_SCHED; PG8_LDA(At, 0, 0); PG8_STAGE(PG8_SA(1, 1), a1 + hstepA, voffA);
            PG8_WAIT_L(8); PG8_BAR; PG8_WAIT_L(0); PG8_MMA(0, 0, At, B0); PG8_BAR; PG8_SCHED;
            PG8_LDB(B1, 0, 1); PG8_STAGE(PG8_SB(0, 0), b2, voffB);
            PG8_BAR; PG8_WAIT_L(0); PG8_MMA(0, 1, At, B1); PG8_BAR;
            PG8_LDA(At, 0, 1); PG8_STAGE(PG8_SA(0, 0), a2, voffA);
            PG8_BAR; PG8_WAIT_L(0); PG8_MMA(1, 0, At, B0); PG8_BAR; PG8_SCHED;
            PG8_STAGE(PG8_SB(0, 1), b2 + hstepB, voffB);
            PG8_WAIT_V(6); PG8_BAR; PG8_MMA(1, 1, At, B1); PG8_BAR;
            PG8_LDB(B0, 1, 0); PG8_SCHED; PG8_LDA(At, 1, 0); PG8_STAGE(PG8_SA(0, 1), a2 + hstepA, voffA);
            PG8_WAIT_L(8); PG8_BAR; PG8_WAIT_L(0); PG8_MMA(0, 0, At, B0); PG8_BAR; PG8_SCHED;
            PG8_LDB(B1, 1, 1); PG8_STAGE(PG8_SB(1, 0), b3, voffB);
            PG8_BAR; PG8_WAIT_L(0); PG8_MMA(0, 1, At, B1); PG8_BAR;
            PG8_LDA(At, 1, 1); PG8_STAGE(PG8_SA(1, 0), a3, voffA);
            PG8_BAR; PG8_WAIT_L(0); PG8_MMA(1, 0, At, B0); PG8_BAR; PG8_SCHED;
            PG8_STAGE(PG8_SB(1, 1), b3 + hstepB, voffB);
            PG8_WAIT_V(6); PG8_BAR; PG8_MMA(1, 1, At, B1); PG8_BAR;
            }
        }
        if constexpr (ALIGN_EPI) { if (wr == 0) PG8_BAR; }
        if constexpr (!Epi::AFTER_DRAIN) { E(acc, cur, wr, wc, fr, fq); S.done(cur); }
        if (!has_next) break;
#pragma unroll
        for (int a = 0; a < 2; ++a)
#pragma unroll
            for (int b = 0; b < 2; ++b)
#pragma unroll
                for (int m = 0; m < 4; ++m)
#pragma unroll
                    for (int n = 0; n < 2; ++n) acc[a][b][m][n] = (f32x4){0.f, 0.f, 0.f, 0.f};
        cur = nxt; cA = nA; cB = nB; ++ui;
        if constexpr (ALIGN_EPI) { if (wr == 1) PG8_BAR; }
    }
    PG8_WAIT_V(0);
    if constexpr (!ALIGN_EPI) { if (wr == 0) PG8_BAR; }
    PG8_BAR;
    if constexpr (Epi::AFTER_DRAIN) { E.fused(acc, cur, wr, wc, fr, fq, lds, wid, lane); S.done(cur); }
#undef PG8_SA
#undef PG8_SB
#undef PG8_STAGE
#undef PG8_LDA
#undef PG8_LDB
#undef PG8_MMA
#undef PG8_WAIT_V
#undef PG8_WAIT_L
#undef PG8_BAR
#undef PG8_SCHED
}
}
namespace att {
typedef unsigned short bf16_t;
using bf16x8 = __attribute__((ext_vector_type(8))) short;
using s16x4  = __attribute__((ext_vector_type(4))) short;
using f32x16 = __attribute__((ext_vector_type(16))) float;
using u32x4  = __attribute__((ext_vector_type(4))) unsigned;
constexpr int   D = 128, NW = 8, QBLK = 32, KVBLK = 64;
constexpr float SCALE = 0.088388347648318440f, LOG2E = 1.4426950408889634f;
constexpr float THR = 8.f;
constexpr int LDQ = 128, LDK = 128;
constexpr int SHM_V = KVBLK * D * 2, SHM_K = KVBLK * D * 2;
constexpr int OFF_WS = 2 * SHM_V + 2 * SHM_K, OFF_TB = OFF_WS + NW * 64 * 4, TBN = 2560, TB0 = 1280, SHM_ATTN = OFF_TB + TBN * 4;
#define KSWZ(row, colB) ((row) * 256 + ((colB) ^ (((row) & 7) << 4)))
#define SBAR() __builtin_amdgcn_sched_barrier(0)
__device__ __forceinline__ int crow(int r, int hi) { return (r & 3) + 8 * (r >> 2) + 4 * hi; }
__device__ __forceinline__ unsigned cvtpk(float lo, float hi) { unsigned r; asm volatile("v_cvt_pk_bf16_f32 %0, %1, %2" : "=v"(r) : "v"(lo), "v"(hi)); return r; }
__device__ __forceinline__ void partialSM_fix(f32x16& p0, f32x16& p1) {
#pragma unroll
  for (int r = 0; r < 16; ++r) p0[r] = __builtin_amdgcn_exp2f(p0[r]);
}
__device__ __forceinline__ void partialSM_b(f32x16& p0, f32x16& p1, float& m_reg, float& mn, float& alpha, const float* tbp) {
  constexpr float C = SCALE * LOG2E;
#pragma unroll
  for (int r = 0; r < 16; ++r) { const int o = (r & 3) + 8 * (r >> 2); p0[r] = fmaf(p0[r], C, tbp[o]); p1[r] = fmaf(p1[r], C, tbp[32 + o]); }
  float pmax = p0[0];
#pragma unroll
  for (int r = 1; r < 16; ++r) pmax = fmaxf(pmax, p0[r]);
#pragma unroll
  for (int r = 0; r < 16; ++r) pmax = fmaxf(pmax, p1[r]);
  { auto rr = __builtin_amdgcn_permlane32_swap(__float_as_uint(pmax), __float_as_uint(pmax), false, false);
    pmax = fmaxf(__uint_as_float(rr[0]), __uint_as_float(rr[1])); }
  if (__builtin_expect(__all(pmax - m_reg <= THR * LOG2E), 1)) { mn = m_reg; alpha = 1.f; }
  else { mn = fmaxf(m_reg, pmax); alpha = __builtin_amdgcn_exp2f(m_reg - mn); m_reg = mn; }
#pragma unroll
  for (int r = 0; r < 16; ++r) p0[r] = p0[r] - mn;
#pragma unroll
  for (int r = 0; r < 16; ++r) p1[r] = p1[r] - mn;
#pragma unroll
  for (int r = 0; r < 16; ++r) p0[r] = __builtin_amdgcn_exp2f(p0[r]);
}
__device__ __forceinline__ void finishSM(f32x16& p0, f32x16& p1, float alpha, float& l_reg, bf16x8& pa0, bf16x8& pa1, bf16x8& pa2, bf16x8& pa3) {
#pragma unroll
  for (int r = 0; r < 16; ++r) p1[r] = __builtin_amdgcn_exp2f(p1[r]);
  float ps = 0;
#pragma unroll
  for (int r = 0; r < 16; ++r) ps += p0[r];
#pragma unroll
  for (int r = 0; r < 16; ++r) ps += p1[r];
  { auto rr = __builtin_amdgcn_permlane32_swap(__float_as_uint(ps), __float_as_uint(ps), false, false);
    ps = __uint_as_float(rr[0]) + __uint_as_float(rr[1]); }
  l_reg = l_reg * alpha + ps;
#define PK4(P, BASE, OUT) do { unsigned a0 = cvtpk(P[BASE + 0], P[BASE + 1]), a1 = cvtpk(P[BASE + 2], P[BASE + 3]);   \
    unsigned b0 = cvtpk(P[BASE + 4], P[BASE + 5]), b1 = cvtpk(P[BASE + 6], P[BASE + 7]);                              \
    auto r0 = __builtin_amdgcn_permlane32_swap(a0, b0, false, false); auto r1 = __builtin_amdgcn_permlane32_swap(a1, b1, false, false); \
    u32x4 w = {r0[0], r1[0], r0[1], r1[1]}; OUT = *reinterpret_cast<bf16x8*>(&w); } while (0)
  PK4(p0, 0, pa0); PK4(p0, 8, pa1); PK4(p1, 0, pa2); PK4(p1, 8, pa3);
#undef PK4
}
__device__ __forceinline__ void qkt(f32x16& p0, f32x16& p1, const char* Ks, const bf16x8* qr, int r32, int hi) {
  p0 = f32x16{}; p1 = f32x16{};
#pragma unroll
  for (int d0 = 0; d0 < 8; ++d0) { const int cb = (d0 * 16 + hi * 8) * 2;
    const bf16x8 b0 = *reinterpret_cast<const bf16x8*>(Ks + KSWZ(r32, cb));
    const bf16x8 b1 = *reinterpret_cast<const bf16x8*>(Ks + KSWZ(32 + r32, cb));
    p0 = __builtin_amdgcn_mfma_f32_32x32x16_bf16(b0, qr[d0], p0, 0, 0, 0);
    p1 = __builtin_amdgcn_mfma_f32_32x32x16_bf16(b1, qr[d0], p1, 0, 0, 0); }
}
__device__ __forceinline__ int v_st(int k, int c) { const int kk = (k & ~0xC) | ((k & 4) << 1) | ((k & 8) >> 1); return ((kk >> 3) * 4 + (c >> 5)) * 512 + ((kk & 7) * 32 + (c & 31)) * 2; }
__device__ __forceinline__ int v_rd_base(int lane) { return ((lane & 3) << 3) | (((lane >> 2) & 3) << 6) | (((lane >> 4) & 1) << 5) | (((lane >> 5) & 1) << 8); }
constexpr int v_rd_off(int d0, int ks, int half) { return d0 * 512 + ks * 4096 + half * 2048; }
template <int OFF> __device__ __forceinline__ s16x4 tr_read(int vb) {
  s16x4 r; asm volatile("ds_read_b64_tr_b16 %0, %1 offset:%2" : "=&v"(r) : "v"(vb), "i"(OFF) : "memory"); return r;
}
template <int D0> __device__ __forceinline__ void pv_one(f32x16& od, int vb, bf16x8 pa0, bf16x8 pa1, bf16x8 pa2, bf16x8 pa3) {
  const s16x4 l0 = tr_read<v_rd_off(D0, 0, 0)>(vb), h0 = tr_read<v_rd_off(D0, 0, 1)>(vb), l1 = tr_read<v_rd_off(D0, 1, 0)>(vb), h1 = tr_read<v_rd_off(D0, 1, 1)>(vb);
  const s16x4 l2 = tr_read<v_rd_off(D0, 2, 0)>(vb), h2 = tr_read<v_rd_off(D0, 2, 1)>(vb), l3 = tr_read<v_rd_off(D0, 3, 0)>(vb), h3 = tr_read<v_rd_off(D0, 3, 1)>(vb);
  asm volatile("s_waitcnt lgkmcnt(0)" ::: "memory"); SBAR();
#define PK(L, H) (bf16x8){L[0], L[1], L[2], L[3], H[0], H[1], H[2], H[3]}
  od = __builtin_amdgcn_mfma_f32_32x32x16_bf16(pa0, PK(l0, h0), od, 0, 0, 0);
  od = __builtin_amdgcn_mfma_f32_32x32x16_bf16(pa1, PK(l1, h1), od, 0, 0, 0);
  od = __builtin_amdgcn_mfma_f32_32x32x16_bf16(pa2, PK(l2, h2), od, 0, 0, 0);
  od = __builtin_amdgcn_mfma_f32_32x32x16_bf16(pa3, PK(l3, h3), od, 0, 0, 0);
#undef PK
}
__device__ __forceinline__ void pv_d0(f32x16* o, int vb, bf16x8 pa0, bf16x8 pa1, bf16x8 pa2, bf16x8 pa3) {
  pv_one<0>(o[0], vb, pa0, pa1, pa2, pa3); pv_one<1>(o[1], vb, pa0, pa1, pa2, pa3); pv_one<2>(o[2], vb, pa0, pa1, pa2, pa3); pv_one<3>(o[3], vb, pa0, pa1, pa2, pa3);
}
template <bool BIAS, int SDEPTH, bool FIXM = false>
__device__ __forceinline__ void attn_body(const bf16_t* __restrict__ Qb, const bf16_t* __restrict__ Kh, const bf16_t* __restrict__ Vh, bf16_t* __restrict__ Ob, int NT, int koff, char* lds, int tstep = KVBLK) {
  int tid_ = threadIdx.x; asm volatile("" : "+v"(tid_));
  const int tid = tid_, wid = tid >> 6, lane = tid & 63, r32 = lane & 31, hi = lane >> 5;
  char* V_lds = lds; char* K_lds = lds + 2 * SHM_V;
  float* ws = (float*)(lds + OFF_WS) + wid * 64; float* li_l = ws; float* al_l = ws + 32;
  const float* tb0 = (const float*)(lds + OFF_TB) + (koff + TB0 - (wid * QBLK + r32) + 4 * hi);
  float m_reg = -1e30f, l_reg = 0; f32x16 o[4] = {}; bf16x8 qr[8];
  const bf16_t* Qw = Qb + (long)(wid * QBLK + r32) * LDQ + hi * 8;
#pragma unroll
  for (int d0 = 0; d0 < 8; ++d0) qr[d0] = *reinterpret_cast<const bf16x8*>(Qw + d0 * 16);
  const int sr = tid >> 4, sc = (tid & 15) * 8, vst0 = v_st(sr, sc), vst1 = v_st(32 + sr, sc);
  const int vb0 = (int)(uintptr_t)V_lds + v_rd_base(lane);
  struct { bf16x8 vs0, vs1, ks0, ks1; } sr_[SDEPTH];
#define SLOAD(i, k0) do { sr_[i].vs0 = *reinterpret_cast<const bf16x8*>(&Vh[(long)((k0) + sr) * LDK + sc]); sr_[i].vs1 = *reinterpret_cast<const bf16x8*>(&Vh[(long)((k0) + 32 + sr) * LDK + sc]); \
    sr_[i].ks0 = *reinterpret_cast<const bf16x8*>(&Kh[(long)((k0) + sr) * LDK + sc]); sr_[i].ks1 = *reinterpret_cast<const bf16x8*>(&Kh[(long)((k0) + 32 + sr) * LDK + sc]); } while (0)
#define SWRITE(b, i) do { *(bf16x8*)(V_lds + (b) * SHM_V + vst0) = sr_[i].vs0;          \
    *(bf16x8*)(V_lds + (b) * SHM_V + vst1) = sr_[i].vs1; const int kc = sc * 2;               \
    *(bf16x8*)(K_lds + (b) * SHM_K + KSWZ(sr, kc)) = sr_[i].ks0;                       \
    *(bf16x8*)(K_lds + (b) * SHM_K + KSWZ(32 + sr, kc)) = sr_[i].ks1; } while (0)
#define SWAIT() do { if constexpr (SDEPTH == 2) asm volatile("s_waitcnt vmcnt(4)" ::: "memory"); else asm volatile("s_waitcnt vmcnt(0)" ::: "memory"); } while (0)
#define RESC(a) do { if constexpr (!FIXM) if (__any((a) < 1.f)) { if (hi == 0) al_l[r32] = (a); asm volatile("s_waitcnt lgkmcnt(0)" ::: "memory"); \
    _Pragma("unroll") for (int d = 0; d < 4; ++d) _Pragma("unroll") for (int r = 0; r < 16; ++r) o[d][r] *= al_l[crow(r, hi)]; } } while (0)
#define PSM(P0, P1, MN, AL, t) do { if constexpr (BIAS) partialSM_b(P0, P1, m_reg, MN, AL, tb0 + (t) * tstep); else { static_assert(BIAS || FIXM, "mixer A: fixed reference, or the BIAS body with a zero table"); partialSM_fix(P0, P1); AL = 1.f; } } while (0)
  f32x16 pA0, pA1, pB0, pB1; float mnA, mnB, alA, alB; bf16x8 pa0, pa1, pa2, pa3;
  constexpr int SE = 0, SO = SDEPTH - 1;
  SLOAD(SE, 0); asm volatile("s_waitcnt vmcnt(0)" ::: "memory"); SWRITE(0, SE); __syncthreads();
  qkt(pA0, pA1, K_lds, qr, r32, hi); PSM(pA0, pA1, mnA, alA, 0);
  SLOAD(SO, KVBLK); if constexpr (SDEPTH == 2) { if (2 < NT) SLOAD(SE, 2 * KVBLK); }
  SWAIT(); SWRITE(1, SO); __syncthreads();
  for (int j = 1; j + 1 < NT; j += 2) {
    SBAR(); qkt(pB0, pB1, K_lds + SHM_K, qr, r32, hi);
    finishSM(pA0, pA1, alA, l_reg, pa0, pa1, pa2, pa3); SBAR();
    SLOAD(SO, (j + SDEPTH) * KVBLK); SBAR();
    pv_d0(o, vb0, pa0, pa1, pa2, pa3); PSM(pB0, pB1, mnB, alB, j);
    __syncthreads(); SWAIT(); SWRITE(0, SE);
    RESC(alB); __syncthreads();
    SBAR(); qkt(pA0, pA1, K_lds, qr, r32, hi);
    finishSM(pB0, pB1, alB, l_reg, pa0, pa1, pa2, pa3); SBAR();
    if (SDEPTH == 1 || j + 3 < NT) SLOAD(SE, (j + 1 + SDEPTH) * KVBLK); SBAR();
    pv_d0(o, vb0 + SHM_V, pa0, pa1, pa2, pa3); PSM(pA0, pA1, mnA, alA, j + 1);
    __syncthreads(); SWAIT(); SWRITE(1, SO);
    RESC(alA); __syncthreads();
  }
  SBAR(); qkt(pB0, pB1, K_lds + SHM_K, qr, r32, hi);
  finishSM(pA0, pA1, alA, l_reg, pa0, pa1, pa2, pa3); SBAR();
  pv_d0(o, vb0, pa0, pa1, pa2, pa3); PSM(pB0, pB1, mnB, alB, NT - 1);
  __syncthreads(); RESC(alB);
  finishSM(pB0, pB1, alB, l_reg, pa0, pa1, pa2, pa3); SBAR();
  pv_d0(o, vb0 + SHM_V, pa0, pa1, pa2, pa3);
  if (hi == 0) li_l[r32] = l_reg; asm volatile("s_waitcnt lgkmcnt(0)" ::: "memory");
  float rli[16];
#pragma unroll
  for (int r = 0; r < 16; ++r) rli[r] = __builtin_amdgcn_rcpf(li_l[crow(r, hi)]);
  bf16_t* Ow = Ob + (long)(wid * QBLK) * 64;
#pragma unroll
  for (int r = 0; r < 16; ++r) { const int orow = crow(r, hi);
#pragma unroll
    for (int d0 = 0; d0 < 4; ++d0) Ow[(d0 >> 1) * (256 * 64) + orow * 64 + (d0 & 1) * 32 + r32] = (bf16_t)(cvtpk(o[d0][r] * rli[r], 0.f) & 0xffffu); }
  __syncthreads();
#undef SLOAD
#undef SWRITE
#undef SWAIT
#undef RESC
#undef PSM
}
#undef KSWZ
#undef SBAR
}

#define GAS __attribute__((address_space(1)))
#define LAS __attribute__((address_space(3)))
typedef unsigned short bf16;
typedef unsigned v4u __attribute__((ext_vector_type(4)));
typedef float f32x4 __attribute__((ext_vector_type(4)));
typedef short bf16x8 __attribute__((ext_vector_type(8)));
typedef GAS unsigned gu32;
typedef GAS unsigned long long gu64;
#define RLX_AGENT __ATOMIC_RELAXED, __HIP_MEMORY_SCOPE_AGENT
#define LDS_WAIT() asm volatile("s_waitcnt lgkmcnt(0)" ::: "memory")
#define VM_WAIT() asm volatile("s_waitcnt vmcnt(0)" ::: "memory")
__device__ __forceinline__ unsigned long long rt() { return __builtin_amdgcn_s_memrealtime(); }
__device__ __forceinline__ unsigned f2bf(float f) { unsigned u = __builtin_bit_cast(unsigned, f); return (u + 0x7fffu + ((u >> 16) & 1u)) >> 16; }
__device__ __forceinline__ unsigned pk2(float lo, float hi) { return f2bf(lo) | (f2bf(hi) << 16); }

#define XB_TMO      128
#define XB_XCNT(j)  (256  + 64 * (j))
#define XB_XSUB(j)  (1280 + 64 * (j))
#define XB_XGEN(j)  (2304 + 64 * (j))
#define XB_TOP      3328
#define XB_TOPGEN   3392
#define XCD_BAR_WORDS 3456
#define XB_SPIN_CAP (1u << 18)

__device__ __forceinline__ unsigned xb_ld(unsigned* p)              { return __hip_atomic_load(p, __ATOMIC_RELAXED, __HIP_MEMORY_SCOPE_AGENT); }
__device__ __forceinline__ unsigned xb_add(unsigned* p, unsigned v) { return __hip_atomic_fetch_add(p, v, __ATOMIC_RELAXED, __HIP_MEMORY_SCOPE_AGENT); }
__device__ __forceinline__ unsigned xb_xcc_id() { return (unsigned)__builtin_amdgcn_s_getreg((3 << 11) | 20) & 0xFu; }
#define XB_SPIN(cond, bar) do { unsigned _sp = 0; while (cond) { __builtin_amdgcn_s_sleep(1); \
    if ((++_sp & 255u) == 0u) { if (xb_ld(&(bar)[XB_TMO])) break; if (_sp > XB_SPIN_CAP) { atomicAdd(&(bar)[XB_TMO], 1u); break; } } } } while (0)

struct XcdBarrier {
    unsigned* bar; unsigned x;
    volatile LAS unsigned* st;
};

__device__ __forceinline__ XcdBarrier xcd_barrier_post(unsigned* bar, volatile LAS unsigned* st) {
    XcdBarrier b; b.bar = bar; b.x = xb_xcc_id(); b.st = st;
    if (threadIdx.x == 0) (void)xb_add(&bar[XB_XCNT(b.x)], 1u);
    return b;
}
__device__ __forceinline__ void xcd_barrier_complete(unsigned* bar, unsigned x, unsigned& nloc, unsigned& nx) {
    const unsigned G = gridDim.x * gridDim.y * gridDim.z;
    unsigned sum, cnt, mine, sp = 0u;
    for (;;) {
        sum = 0u; cnt = 0u; mine = 0u;
#pragma unroll
        for (unsigned j = 0; j < 16; ++j) { const unsigned c = xb_ld(&bar[XB_XCNT(j)]); sum += c; cnt += (c > 0u) ? 1u : 0u; mine = (j == x) ? c : mine; }
        if (sum == G) break;
        __builtin_amdgcn_s_sleep(1);
        if ((++sp & 255u) == 0u) { if (xb_ld(&bar[XB_TMO])) break; if (sp > XB_SPIN_CAP) { atomicAdd(&bar[XB_TMO], 1u); break; } }
    }
    nloc = mine > 0u ? mine : 1u; nx = cnt > 0u ? cnt : 1u;
}

__device__ __forceinline__ void xcd_barrier(const XcdBarrier& b) {
    asm volatile("s_waitcnt vmcnt(0)" ::: "memory");
    __syncthreads();
    if (threadIdx.x == 0) {
        unsigned* bar = b.bar;
        __builtin_amdgcn_s_waitcnt(0);
        unsigned nloc = b.st[0], nx = b.st[1];
        if (nloc == 0u) { xcd_barrier_complete(bar, b.x, nloc, nx); b.st[0] = nloc; b.st[1] = nx; }
        const unsigned old = xb_add(&bar[XB_XSUB(b.x)], 1u);
        const unsigned gen = old / nloc;
        if (old + 1u == (gen + 1u) * nloc) {
            __builtin_amdgcn_fence(__ATOMIC_RELEASE, "agent");
            asm volatile("s_waitcnt vmcnt(0)" ::: "memory");
            const unsigned og = xb_add(&bar[XB_TOP], 1u);
            const unsigned tg = og / nx;
            if (og + 1u == (tg + 1u) * nx) xb_add(&bar[XB_TOPGEN], 1u);
            else XB_SPIN(xb_ld(&bar[XB_TOPGEN]) == tg, bar);
            __builtin_amdgcn_fence(__ATOMIC_ACQUIRE, "agent");
            xb_add(&bar[XB_XGEN(b.x)], 1u);
            asm volatile("s_waitcnt vmcnt(0)" ::: "memory");
        } else {
            XB_SPIN(xb_ld(&bar[XB_XGEN(b.x)]) == gen, bar);
            __builtin_amdgcn_fence(__ATOMIC_ACQUIRE, "agent");
            asm volatile("s_waitcnt vmcnt(0)" ::: "memory");
        }
    }
    __syncthreads();
}

constexpr int NWAVES = 8;
constexpr int SEQ = 8192, DM = 4096, FF = 11008, NGU = 2 * FF, NIN = 9216;
constexpr int KP = DM + PADK, FP = FF + PADF;
constexpr int HQA = 0, HKA = 16, HVA = 20, HQB = 24, HKB = 40, HVB = 56;
constexpr float ALPHA = 1.18920711500272106671f;
constexpr float LN_EPS = 1e-5f, RMS_EPS = 1e-6f;
constexpr size_t MiB = 1u << 20;
constexpr size_t WS_CTL = 0, CTL_ZERO_BYTES = 512 * 1024;
constexpr size_t WS_STAT = 64 * 1024;
constexpr size_t WS_CV = WS_STAT + (size_t)2 * SEQ * 2 * 4;
static_assert(WS_CV + (size_t)(2 * NIN + 2 * NGU) * 4 <= CTL_ZERO_BYTES, "zeroed region");
constexpr size_t WS_ROPE = 1 * MiB;
constexpr size_t WS_TB = 1 * MiB + 64 * 1024;
constexpr size_t rup(size_t b) { return (b + MiB - 1) / MiB * MiB; }
constexpr size_t WS_WGU1 = 2 * MiB, WS_WD1 = WS_WGU1 + rup((size_t)NGU * KP * 2), WS_WIN = WS_WD1 + rup((size_t)DM * FP * 2), WS_WOUT = WS_WIN + rup((size_t)NIN * KP * 2),
                 WS_WGU2 = WS_WOUT + rup((size_t)DM * KP * 2), WS_WD2 = WS_WGU2 + rup((size_t)NGU * KP * 2);
constexpr size_t WS_XB = WS_WD2 + rup((size_t)DM * FP * 2);
constexpr size_t WS_ACT = WS_XB + rup((size_t)SEQ * KP * 2);
constexpr size_t WS_Y = WS_ACT + rup((size_t)SEQ * FP * 2);
constexpr size_t WS_HB = WS_Y + rup((size_t)SEQ * DM * 4);
constexpr size_t WS_END = WS_HB + rup((size_t)SEQ * KP * 2);
static_assert((size_t)SEQ * NIN * 2 <= (size_t)SEQ * FP * 2, "the projection fits the activation buffer");
constexpr int CW_BAR = 4096;
constexpr int RING_OFF = 0, RING_BYTES = 131072;
constexpr int P0_SCR_PER_WAVE = 64 * 65 * 4;
constexpr int LDSCTL_OFF = 143360;
constexpr int LDS_BYTES = 147456;
static_assert(NWAVES * P0_SCR_PER_WAVE <= LDSCTL_OFF && att::SHM_ATTN <= RING_BYTES && LDSCTL_OFF + 64 <= LDS_BYTES, "LDS map");

__device__ __forceinline__ float wave_sum(float v) {
#pragma unroll
    for (int o = 1; o < 64; o <<= 1) v += __shfl_xor(v, o);
    return v;
}
struct P0Item { const float* src; bf16* dst; int N, K; const float* g; const float* b; float* c1; float* c2; };
__device__ __forceinline__ P0Item p0_item(const float* W, int K, int N, bf16* WT, bool gu, int half, int item, const float* g = nullptr, const float* b = nullptr, float* c1 = nullptr, float* c2 = nullptr) {
    const int nblk = N / 64, kb = item / nblk, nb = item - kb * nblk, k0 = 64 * kb, n0 = 64 * nb;
    const int drow0 = gu ? ((n0 >> 7) << 8) + (n0 & 127) + 128 * half : n0;
    P0Item r; r.src = W + (size_t)k0 * N + n0; r.dst = WT + pg8::blk_off(drow0, k0, K); r.N = N; r.K = 64;
    r.g = g ? g + k0 : nullptr; r.b = g ? b + k0 : nullptr; r.c1 = g ? c1 + drow0 : nullptr; r.c2 = g ? c2 + drow0 : nullptr; return r;
}
__device__ __forceinline__ void p0_load(f32x4 (&v)[16], const P0Item& it, int lane) {
    const unsigned lo = (unsigned)(lane >> 4) * (unsigned)it.N + 4u * (unsigned)(lane & 15);
#pragma unroll
    for (int i = 0; i < 16; ++i) v[i] = __builtin_nontemporal_load((const f32x4*)(it.src + (size_t)(4 * i) * it.N + lo));
}
__device__ __forceinline__ unsigned p0_cvtpk(float lo, float hi) { unsigned r; asm volatile("v_cvt_pk_bf16_f32 %0, %1, %2" : "=v"(r) : "v"(lo), "v"(hi)); return r; }
template <bool NTS> __device__ __forceinline__ void p0_store(const f32x4 (&v)[16], const P0Item& it, LAS float* scr, int lane) {
    LAS float* w = scr + (lane >> 4) * 65 + 4 * (lane & 15);
#pragma unroll
    for (int i = 0; i < 16; ++i) { w[i * 260 + 0] = v[i].x; w[i * 260 + 1] = v[i].y; w[i * 260 + 2] = v[i].z; w[i * 260 + 3] = v[i].w; }
    LDS_WAIT(); asm volatile("" ::: "memory");
    const int c = lane & 7;
    const bool fold = it.g != nullptr;
    f32x4 g0 = {1.f, 1.f, 1.f, 1.f}, g1 = g0, b0 = {0.f, 0.f, 0.f, 0.f}, b1 = b0;
    if (fold) { g0 = *(const f32x4*)(it.g + 8 * c); g1 = *(const f32x4*)(it.g + 8 * c + 4); b0 = *(const f32x4*)(it.b + 8 * c); b1 = *(const f32x4*)(it.b + 8 * c + 4); }
    float a1[8], a2[8];
#pragma unroll
    for (int j = 0; j < 8; ++j) { const int n = (lane >> 3) + 8 * j; const LAS float* s = scr + (8 * c) * 65 + n;
        const float w0 = s[0 * 65], w1 = s[1 * 65], w2 = s[2 * 65], w3 = s[3 * 65], w4 = s[4 * 65], w5 = s[5 * 65], w6 = s[6 * 65], w7 = s[7 * 65];
        v4u o; o.x = p0_cvtpk(w0 * g0.x, w1 * g0.y); o.y = p0_cvtpk(w2 * g0.z, w3 * g0.w); o.z = p0_cvtpk(w4 * g1.x, w5 * g1.y); o.w = p0_cvtpk(w6 * g1.z, w7 * g1.w);
        if (NTS) __builtin_nontemporal_store(o, (GAS v4u*)(it.dst + (size_t)n * it.K + 8 * c)); else *(GAS v4u*)(it.dst + (size_t)n * it.K + 8 * c) = o;
        if (fold) {
            float p1 = (w0 * g0.x + w1 * g0.y) + (w2 * g0.z + w3 * g0.w) + (w4 * g1.x + w5 * g1.y) + (w6 * g1.z + w7 * g1.w);
            float p2 = (w0 * b0.x + w1 * b0.y) + (w2 * b0.z + w3 * b0.w) + (w4 * b1.x + w5 * b1.y) + (w6 * b1.z + w7 * b1.w);
            p1 += __shfl_xor(p1, 1); p1 += __shfl_xor(p1, 2); p1 += __shfl_xor(p1, 4); p2 += __shfl_xor(p2, 1); p2 += __shfl_xor(p2, 2); p2 += __shfl_xor(p2, 4);
            a1[j] = p1; a2[j] = p2; } }
    LDS_WAIT(); asm volatile("" ::: "memory");
    if (fold) {
        if (c == 0) {
#pragma unroll
            for (int j = 0; j < 8; ++j) { scr[(lane >> 3) + 8 * j] = a1[j]; scr[64 + (lane >> 3) + 8 * j] = a2[j]; } }
        LDS_WAIT(); asm volatile("" ::: "memory");
        const float v1 = scr[lane], v2 = scr[64 + lane];
        LDS_WAIT(); asm volatile("" ::: "memory");
        unsafeAtomicAdd(it.c1 + lane, v1); unsafeAtomicAdd(it.c2 + lane, v2);
    }
}
__device__ __forceinline__ int t5_bucket(int rel) {
    const int nb = 16, max_exact = 8; const int ret = rel > 0 ? nb : 0; const int n = rel < 0 ? -rel : rel;
    int large = max_exact + (int)(log((double)(n < 1 ? 1 : n) / (double)max_exact) / log(1024.0 / (double)max_exact) * (double)(nb - max_exact));
    large = large < nb - 1 ? large : nb - 1;
    return ret + (n < max_exact ? n : large);
}
__device__ __forceinline__ void ln_rows2(const float* __restrict__ y0, const float* __restrict__ y1, const float* __restrict__ g, const float* __restrict__ b, float* __restrict__ o0, float* __restrict__ o1, int lane) {
    const GAS f32x4* r0 = (const GAS f32x4*)y0 + lane; const GAS f32x4* r1 = (const GAS f32x4*)y1 + lane;
    f32x4 v[16], w[16]; float s = 0.f, t = 0.f;
#pragma unroll
    for (int j = 0; j < 16; ++j) v[j] = __builtin_nontemporal_load(r0 + 64 * j);
#pragma unroll
    for (int j = 0; j < 16; ++j) w[j] = __builtin_nontemporal_load(r1 + 64 * j);
#pragma unroll
    for (int j = 0; j < 16; ++j) { s += (v[j].x + v[j].y) + (v[j].z + v[j].w); t += (w[j].x + w[j].y) + (w[j].z + w[j].w); }
    const float m0 = wave_sum(s) * (1.f / DM), m1 = wave_sum(t) * (1.f / DM); float s2 = 0.f, t2 = 0.f;
#pragma unroll
    for (int j = 0; j < 16; ++j) { v[j] = v[j] - m0; w[j] = w[j] - m1; s2 += (v[j].x * v[j].x + v[j].y * v[j].y) + (v[j].z * v[j].z + v[j].w * v[j].w); t2 += (w[j].x * w[j].x + w[j].y * w[j].y) + (w[j].z * w[j].z + w[j].w * w[j].w); }
    const float rs0 = 1.f / sqrtf(wave_sum(s2) * (1.f / DM) + LN_EPS), rs1 = 1.f / sqrtf(wave_sum(t2) * (1.f / DM) + LN_EPS);
    const GAS f32x4* gr = (const GAS f32x4*)g + lane; const GAS f32x4* br = (const GAS f32x4*)b + lane;
    GAS f32x4* p0 = (GAS f32x4*)o0 + lane; GAS f32x4* p1 = (GAS f32x4*)o1 + lane;
#pragma unroll
    for (int j = 0; j < 16; ++j) { if ((j & 3) == 0) asm volatile("" ::: "memory");
        const f32x4 gg = gr[64 * j], bb = br[64 * j]; p0[64 * j] = v[j] * rs0 * gg + bb; p1[64 * j] = w[j] * rs1 * gg + bb; }
}
struct Args { const float* in[18]; float* out; unsigned char* ws; };
constexpr int I_GU = (DM / 64) * (FF / 64), I_D = (FF / 64) * (DM / 64), I_IN = (DM / 64) * (NIN / 64), I_OUT = (DM / 64) * (DM / 64);
constexpr int IT_R0 = 2 * I_GU + I_IN + I_OUT, IT_R1 = IT_R0 + I_D, IT_R2 = IT_R1 + 2 * I_GU, IT_R3 = IT_R2 + I_D;
__device__ __forceinline__ P0Item decode_item(const Args& args, int it, int lane) {
    unsigned char* ws = args.ws; int r = it; float* cv = (float*)(ws + WS_CV);
    if (r < I_GU) return p0_item(args.in[1], DM, FF, (bf16*)(ws + WS_WGU1), true, 0, r); r -= I_GU;
    if (r < I_GU) return p0_item(args.in[2], DM, FF, (bf16*)(ws + WS_WGU1), true, 1, r); r -= I_GU;
    if (r < I_IN) return p0_item(args.in[6], DM, NIN, (bf16*)(ws + WS_WIN), false, 0, r, args.in[4], args.in[5], cv, cv + NIN); r -= I_IN;
    if (r < I_OUT) return p0_item(args.in[10], DM, DM, (bf16*)(ws + WS_WOUT), false, 0, r); r -= I_OUT;
    if (r < I_D) return p0_item(args.in[3], FF, DM, (bf16*)(ws + WS_WD1), false, 0, r); r -= I_D;
    if (r < I_GU) return p0_item(args.in[13], DM, FF, (bf16*)(ws + WS_WGU2), true, 0, r, args.in[11], args.in[12], cv + 2 * NIN, cv + 2 * NIN + NGU); r -= I_GU;
    if (r < I_GU) return p0_item(args.in[14], DM, FF, (bf16*)(ws + WS_WGU2), true, 1, r, args.in[11], args.in[12], cv + 2 * NIN, cv + 2 * NIN + NGU); r -= I_GU;
    return p0_item(args.in[15], FF, DM, (bf16*)(ws + WS_WD2), false, 0, r);
}
template <bool NTS> __device__ __forceinline__ void convert_items(const Args& args, int first, int end, int widx, int wstride, LAS float* scr, int lane) {
    f32x4 va[16], vb[16]; P0Item ia, ib; int it = first + widx;
    if (it < end) { ia = decode_item(args, it, lane); p0_load(va, ia, lane); }
    while (it < end) {
        const int it1 = it + wstride, it2 = it + 2 * wstride;
        if (it1 < end) { ib = decode_item(args, it1, lane); p0_load(vb, ib, lane); }
        p0_store<NTS>(va, ia, scr, lane);
        if (it1 >= end) break;
        if (it2 < end) { ia = decode_item(args, it2, lane); p0_load(va, ia, lane); }
        p0_store<NTS>(vb, ib, scr, lane);
        it = it2;
    }
}
__device__ __forceinline__ const Args* kargs() { auto p = __builtin_amdgcn_kernarg_segment_ptr(); asm volatile("" : "+s"(p)); return (const Args*)p; }
#define KARGS() const Args* pa = kargs(); (void)pa
#define MIXA_FIXM(out) bool out; { float gq_ = fmaxf(fabsf(pa->in[7][lane]), fabsf(pa->in[7][lane + 64])), gk_ = fmaxf(fabsf(pa->in[8][lane]), fabsf(pa->in[8][lane + 64])); \
    _Pragma("unroll") for (int o_ = 1; o_ < 64; o_ <<= 1) { gq_ = fmaxf(gq_, __shfl_xor(gq_, o_)); gk_ = fmaxf(gk_, __shfl_xor(gk_, o_)); } \
    out = __builtin_amdgcn_readfirstlane((att::SCALE * att::LOG2E * 128.0f * gq_ * gk_ < 60.0f) ? 1 : 0) != 0; }
#define WS_ (pa->ws)
#define Wgu1 ((bf16*)(WS_ + WS_WGU1))
#define Wd1 ((bf16*)(WS_ + WS_WD1))
#define Win ((bf16*)(WS_ + WS_WIN))
#define Wout ((bf16*)(WS_ + WS_WOUT))
#define Wgu2 ((bf16*)(WS_ + WS_WGU2))
#define Wd2 ((bf16*)(WS_ + WS_WD2))
#define XB ((bf16*)(WS_ + WS_XB))
#define ACT ((bf16*)(WS_ + WS_ACT))
#define PROJ ACT
#define AO XB
#define YB ((bf16*)(WS_ + WS_HB))
#define Y ((float*)(WS_ + WS_Y))
#define STAT0 ((float*)(WS_ + WS_STAT))
#define STAT1 (STAT0 + 2 * SEQ)
#define CV ((float*)(WS_ + WS_CV))
#define ROPE ((float*)(WS_ + WS_ROPE))
#define TB ((float*)(WS_ + WS_TB))
__global__ void __launch_bounds__(NWAVES * 64, 2) fwd_kernel(Args args) {
    extern __shared__ __attribute__((aligned(16))) unsigned char lds[];
    LAS unsigned char* ldsl = (LAS unsigned char*)lds;
#define PHASE_TID() int tid_ = threadIdx.x; asm volatile("" : "+v"(tid_)); const int tid = tid_, lane = tid & 63, wave = __builtin_amdgcn_readfirstlane(tid >> 6), gw = vcu * NWAVES + wave; (void)lane; (void)gw; (void)tid
    const int G = gridDim.x, bx = blockIdx.x, vcu = (G % 8 == 0) ? (bx % 8) * (G / 8) + bx / 8 : bx;
    const int NGW = G * NWAVES;
    { int t0_ = threadIdx.x; asm volatile("" : "+v"(t0_)); for (int u = t0_; u < (LDS_BYTES - LDSCTL_OFF) / 4; u += NWAVES * 64) ((LAS unsigned*)(ldsl + LDSCTL_OFF))[u] = 0u; }
    __syncthreads();
    XcdBarrier bar; { KARGS(); bar = xcd_barrier_post((unsigned*)((gu32*)(WS_ + WS_CTL) + CW_BAR), (volatile LAS unsigned*)(ldsl + LDSCTL_OFF + 32)); }

    {
        KARGS(); PHASE_TID();
        LAS float* scr = (LAS float*)(ldsl + wave * P0_SCR_PER_WAVE);
        convert_items<false>(*pa, 0, IT_R3, gw, NGW, scr, lane);
        const size_t n8 = (size_t)SEQ * DM / 8;
        for (size_t i0 = (size_t)gw * 64 + lane; i0 < n8; i0 += (size_t)NGW * 64 * 4) {
            f32x4 a[4], b[4];
#pragma unroll
            for (int r = 0; r < 4; ++r) { const size_t i = i0 + (size_t)r * NGW * 64; if (i < n8) { a[r] = __builtin_nontemporal_load((const GAS f32x4*)(pa->in[0] + i * 8)); b[r] = __builtin_nontemporal_load((const GAS f32x4*)(pa->in[0] + i * 8 + 4)); } }
#pragma unroll
            for (int r = 0; r < 4; ++r) { const size_t i = i0 + (size_t)r * NGW * 64; if (i < n8) {
                v4u o; o.x = pk2(a[r].x, a[r].y); o.y = pk2(a[r].z, a[r].w); o.z = pk2(b[r].x, b[r].y); o.w = pk2(b[r].z, b[r].w);
                *(GAS v4u*)(XB + pg8::blk_off((int)(i / (DM / 8)), (int)(i % (DM / 8)) * 8, DM)) = o; } }
        }
        for (int e = bx * (NWAVES * 64) + tid; e < 128 * 32; e += G * NWAVES * 64) {
            const int pos = e >> 5, i = e & 31; const float inv = powf(10000.0f, -(float)(2 * i) / 64.0f); const float ang = (float)pos * inv;
            ROPE[2 * e] = cosf(ang); ROPE[2 * e + 1] = sinf(ang); }
        for (int e = bx * (NWAVES * 64) + tid; e < 16 * att::TBN; e += G * NWAVES * 64) {
            const int h = e / att::TBN, d = e % att::TBN - att::TB0; const int ad = d < 0 ? -d : d;
            const int cnt = (ad <= 64 ? 1 : 0) + (((ad & 3) == 0 && ad <= 256) ? 1 : 0) + (((ad & 15) == 0 && ad <= 1024) ? 1 : 0);
            float v = -INFINITY;
            if (cnt > 0) v = (pa->in[9][t5_bucket(d) * 16 + h] + logf((float)cnt)) * 1.4426950408889634f;
            TB[e] = v; }
    }
    xcd_barrier(bar);

    { KARGS(); pg8::Gemm g{XB, Wgu1, SEQ, NGU, DM}; pg8::StaticOrder S; S.init(SEQ, NGU, G, bx);
      pg8::EpiSwiGLU E{ACT, FF, 1.0f};
      pg8::gemm_phase<pg8::EpiSwiGLU, pg8::StaticOrder, true, true>(ldsl + RING_OFF, g, S, E); }
    xcd_barrier(bar);
    { KARGS(); pg8::Gemm g{ACT, Wd1, SEQ, DM, FF}; pg8::StaticOrder S; S.init(SEQ, DM, G, bx);
      typedef pg8::EpiResN<false, true, true, 1> Epi; Epi E{pa->in[0], Y, YB, nullptr, nullptr, nullptr, STAT0};
      pg8::gemm_phase<Epi, pg8::StaticOrder, true, true>(ldsl + RING_OFF, g, S, E); }
    xcd_barrier(bar);
    { KARGS(); pg8::Gemm g{YB, Win, SEQ, NIN, DM}; pg8::StaticOrder S; S.init(SEQ, NIN, G, bx);
      pg8::EpiBf16HeadsN E{PROJ, SEQ, STAT0, CV, CV + NIN};
      pg8::gemm_phase<pg8::EpiBf16HeadsN, pg8::StaticOrder, true, true>(ldsl + RING_OFF, g, S, E); }
    xcd_barrier(bar);
    {
        KARGS(); PHASE_TID();
        const float* qg = pa->in[7]; const float* kg = pa->in[8];
        const float qg0 = qg[2 * lane], qg1 = qg[2 * lane + 1], kg0 = kg[2 * lane], kg1 = kg[2 * lane + 1];
        MIXA_FIXM(fixm);
        for (int base = gw; base < 20 * SEQ; base += 8 * NGW) {
            unsigned w[8];
#pragma unroll
            for (int r = 0; r < 8; ++r) { const int idx = base + r * NGW; w[r] = idx < 20 * SEQ ? *((const GAS unsigned*)(PROJ + (size_t)idx * 128) + lane) : 0u; }
#pragma unroll
            for (int r = 0; r < 8; ++r) { const int idx = base + r * NGW; if (idx >= 20 * SEQ) break;
                const int hh = idx / SEQ, t = idx - hh * SEQ;
                const int pos = lane < 32 ? (t >> 6) : (t & 63), fi = lane & 31;
                const float c = ROPE[2 * (pos * 32 + fi)], s = ROPE[2 * (pos * 32 + fi) + 1];
                const float x1 = __uint_as_float(w[r] << 16), x2 = __uint_as_float(w[r] & 0xffff0000u);
                const float ss = wave_sum(x1 * x1 + x2 * x2);
                const float rs = 1.0f / sqrtf(ss * (1.0f / 128.0f) + RMS_EPS);
                const float qs = (hh < 16 && fixm) ? att::SCALE * att::LOG2E : 1.0f;
                const float n1 = x1 * rs * (hh < 16 ? qg0 : kg0) * qs, n2 = x2 * rs * (hh < 16 ? qg1 : kg1) * qs;
                *((GAS unsigned*)(PROJ + (size_t)idx * 128) + lane) = pk2(n1 * c - n2 * s, n1 * s + n2 * c); }
        }
    }
    xcd_barrier(bar);
    {
        KARGS(); PHASE_TID();
        MIXA_FIXM(fixm);
        if (fixm) {
            for (int u = vcu; u < 512; u += G) { const int head = u >> 5, qblk = u & 31, P0 = qblk * 256, kvh = head >> 2;
                att::attn_body<false, 2, true>(PROJ + ((size_t)(HQA + head) * SEQ + P0) * 128, PROJ + (size_t)(HKA + kvh) * SEQ * 128, PROJ + (size_t)(HVA + kvh) * SEQ * 128, AO + pg8::blk_off(P0, head * 128, DM), SEQ / 64, 0, (char*)lds); }
        }
        for (int u = vcu + (fixm ? 512 : 0); u < 1024; u += G) {
            const bool isB = u >= 512; const int head = (u & 511) >> 5, qblk = u & 31, P0 = qblk * 256;
            for (int e = tid; e < att::TBN; e += NWAVES * 64) ((LAS float*)(ldsl + att::OFF_TB))[e] = isB ? TB[head * att::TBN + e] : 0.f;
            const int ks = isB ? (P0 - 1024 < 0 ? 0 : P0 - 1024) : 0, ke = isB ? (P0 + 1280 > SEQ ? SEQ : P0 + 1280) : SEQ;
            const int hq = isB ? HQB + head : HQA + head, hk = isB ? HKB + head : HKA + (head >> 2), hv = isB ? HVB + head : HVA + (head >> 2);
            att::attn_body<true, 1>(PROJ + ((size_t)hq * SEQ + P0) * 128, PROJ + ((size_t)hk * SEQ + ks) * 128, PROJ + ((size_t)hv * SEQ + ks) * 128,
                                    AO + pg8::blk_off(P0, (isB ? 2048 : 0) + head * 128, DM), (ke - ks) / 64, isB ? ks - P0 : 0, (char*)lds, isB ? att::KVBLK : 0);
        }
    }
    xcd_barrier(bar);
    { KARGS(); pg8::Gemm g{AO, Wout, SEQ, DM, DM}; pg8::StaticOrder S; S.init(SEQ, DM, G, bx);
      typedef pg8::EpiResN<true, true, true, 2> Epi; Epi E{Y, Y, YB, STAT0, pa->in[4], pa->in[5], STAT1};
      pg8::gemm_phase<Epi, pg8::StaticOrder, true, true>(ldsl + RING_OFF, g, S, E); }
    xcd_barrier(bar);
    { KARGS(); pg8::Gemm g{YB, Wgu2, SEQ, NGU, DM}; pg8::StaticOrder S; S.init(SEQ, NGU, G, bx);
      pg8::EpiSwiGLUN E{ACT, FF, STAT1, CV + 2 * NIN, CV + 2 * NIN + NGU};
      pg8::gemm_phase<pg8::EpiSwiGLUN, pg8::StaticOrder, true, true>(ldsl + RING_OFF, g, S, E); }
    xcd_barrier(bar);
    { KARGS(); pg8::Gemm g{ACT, Wd2, SEQ, DM, FF}; pg8::StaticOrder S; S.init(SEQ, DM, G, bx);
      typedef pg8::EpiResN<true, false, false, 1> Epi; Epi E{Y, Y, nullptr, STAT1, pa->in[11], pa->in[12], nullptr};
      pg8::gemm_phase<Epi, pg8::StaticOrder, true, true>(ldsl + RING_OFF, g, S, E); }
    xcd_barrier(bar);
    { KARGS(); PHASE_TID();
    for (int m = gw; m + NGW < SEQ; m += 2 * NGW) ln_rows2(Y + (size_t)m * DM, Y + (size_t)(m + NGW) * DM, pa->in[16], pa->in[17], pa->out + (size_t)m * DM, pa->out + (size_t)(m + NGW) * DM, lane);
    }
}

extern "C" void kernel_launch(void* const* d_in, const int* in_sizes, int n_in, void* d_out, int out_size, void* d_ws, size_t ws_size, hipStream_t stream) {
    static int grid = 0;
    if (grid == 0) {
        if (n_in != 18 || in_sizes[0] != SEQ * DM || out_size != SEQ * DM || ws_size < WS_END) {
            fprintf(stderr, "kernel_launch: built for 18 inputs, x/out of %d floats, >= %zu bytes of workspace; got n_in %d, in0 %d, out %d, ws %zu; nothing launched\n", SEQ * DM, (size_t)WS_END, n_in, n_in > 0 ? in_sizes[0] : -1, out_size, ws_size);
            grid = -1; return; }
        int dev = 0, cus = 0, per_cu = 0;
        if (hipGetDevice(&dev) != hipSuccess || hipDeviceGetAttribute(&cus, hipDeviceAttributeMultiprocessorCount, dev) != hipSuccess) { fprintf(stderr, "kernel_launch: device query failed\n"); grid = -1; return; }
        if (hipFuncSetAttribute((const void*)fwd_kernel, hipFuncAttributeMaxDynamicSharedMemorySize, LDS_BYTES) != hipSuccess) { fprintf(stderr, "kernel_launch: hipFuncSetAttribute failed\n"); grid = -1; return; }
        if (hipOccupancyMaxActiveBlocksPerMultiprocessor(&per_cu, (const void*)fwd_kernel, NWAVES * 64, LDS_BYTES) != hipSuccess || per_cu < 1)
            fprintf(stderr, "kernel_launch: note: occupancy query reports %d workgroups per CU\n", per_cu);
        (void)hipGetLastError();
        grid = cus;
    }
    if (grid < 0) return;
    if (hipMemsetAsync((char*)d_ws + WS_CTL, 0, CTL_ZERO_BYTES, stream) != hipSuccess) { fprintf(stderr, "kernel_launch: hipMemsetAsync failed\n"); return; }
    Args a{};
    for (int i = 0; i < 18; ++i) a.in[i] = (const float*)d_in[i];
    a.out = (float*)d_out; a.ws = (unsigned char*)d_ws;
    hipLaunchKernelGGL(fwd_kernel, dim3(grid), dim3(NWAVES * 64), LDS_BYTES, stream, a);
    const hipError_t le = hipPeekAtLastError();
    if (le != hipSuccess) fprintf(stderr, "kernel_launch: launch failed: %s\n", hipGetErrorName(le));
}
```

```cpp
#include <hip/hip_runtime.h>
#ifndef PADK
#define PADK 0
#endif
#ifndef PADF
#define PADF 0
#endif
#include <hip/hip_bf16.h>
#include <cstdio>
#include <cstdint>
#include <cmath>
namespace pg8 {
#define PG8_LAS __attribute__((address_space(3)))
typedef unsigned short bf16_t;
typedef short bf16x8 __attribute__((ext_vector_type(8)));
typedef float f32x4 __attribute__((ext_vector_type(4)));
typedef unsigned u32x4 __attribute__((ext_vector_type(4)));
constexpr int BM = 256, BK = 64, HALF = 128, HTB = HALF * BK * 2  , STAGE_BYTES = 8 * HTB, NXCD = 8, WGM = 8;

__host__ __device__ __forceinline__ int lds_byte(int r, int c) { const int st = (r >> 4) * 2 + (c >> 5), rr = r & 15, cc = c & 31, ob = rr * 64 + cc * 2; return st * 1024 + (ob ^ (((ob >> 9) & 1) << 5)); }
__host__ __device__ __forceinline__ void stage_rc(int b, int& R, int& C) { const int st = b / 1024, sb = b % 1024, swz = sb ^ (((sb >> 9) & 1) << 5); R = (st >> 1) * 16 + swz / 64; C = (st & 1) * 32 + (swz % 64) / 2; }
__host__ __device__ __forceinline__ int perm32(int rho) { const int n = rho >> 4, i = rho & 15; return 8 * (i >> 2) + 4 * n + (i & 3); }

struct Unit { int pm, pn; };
struct Gemm { const bf16_t* A; const bf16_t* Bt; int M, N, K; };
__host__ __device__ __forceinline__ size_t blk_off(int r, int k, int K) { return ((size_t)(r >> 8) * (K >> 6) + (k >> 6)) * (size_t)(256 * 64) + (size_t)(r & 255) * 64 + (k & 63); }

struct StaticOrder {
    int nM, nN, nwg, G, c;
    __host__ __device__ void init(int M, int N, int G_, int c_) { nM = M / BM; nN = N / BM; nwg = nM * nN; G = G_; c = c_; }
    __host__ __device__ bool next(int i, Unit& u) const {
        const long L = (long)i * G + c; if (L >= nwg) return false;
        int wgid = (int)L; { const int q = nwg / NXCD, r = nwg % NXCD, xcd = wgid % NXCD, off = wgid / NXCD; wgid = (xcd < r ? xcd * (q + 1) : r * (q + 1) + (xcd - r) * q) + off; }
        const int nig = WGM * nN, gid = wgid / nig, fm = gid * WGM, gsz = (nM - fm) < WGM ? (nM - fm) : WGM;
        u.pm = fm + ((wgid % nig) % gsz); u.pn = (wgid % nig) / gsz; return true;
    }
    __device__ __forceinline__ void a_ready(const Unit&) const {}
    __device__ __forceinline__ void done(const Unit&) const {}
};

typedef float f32x2 __attribute__((ext_vector_type(2)));
__device__ __forceinline__ unsigned cvt_pk_bf16(float lo, float hi) { unsigned r; asm volatile("v_cvt_pk_bf16_f32 %0, %1, %2" : "=v"(r) : "v"(lo), "v"(hi)); return r; }
struct EpiBf16 {
    static constexpr bool PERM = true, AFTER_DRAIN = false;
    bf16_t* O; int ldc;
    __device__ __forceinline__ void operator()(const f32x4 (&acc)[2][2][4][2], const Unit& u, int wr, int wc, int fr, int fq) const {
        const int row0 = u.pm * BM + wr * 64 + fr, col0 = u.pn * BM + wc * 32 + 8 * fq;
#pragma unroll
        for (int ai = 0; ai < 2; ++ai)
#pragma unroll
            for (int m = 0; m < 4; ++m) { bf16_t* rowp = O + (size_t)(row0 + ai * HALF + m * 16) * ldc + col0;
#pragma unroll
                for (int bj = 0; bj < 2; ++bj) { const f32x4 v0 = acc[ai][bj][m][0], v1 = acc[ai][bj][m][1];
                    u32x4 w; w.x = cvt_pk_bf16(v0[0], v0[1]); w.y = cvt_pk_bf16(v0[2], v0[3]); w.z = cvt_pk_bf16(v1[0], v1[1]); w.w = cvt_pk_bf16(v1[2], v1[3]);
                    *(u32x4*)(rowp + bj * HALF) = w; } }
    }
};
struct EpiBf16Heads {
    static constexpr bool PERM = true, AFTER_DRAIN = false;
    bf16_t* O; int rows;
    __device__ __forceinline__ void operator()(const f32x4 (&acc)[2][2][4][2], const Unit& u, int wr, int wc, int fr, int fq) const {
        const int row0 = u.pm * BM + wr * 64 + fr, col0 = wc * 32 + 8 * fq;
#pragma unroll
        for (int bj = 0; bj < 2; ++bj) { bf16_t* hb = O + (size_t)(2 * u.pn + bj) * rows * 128 + col0;
#pragma unroll
            for (int ai = 0; ai < 2; ++ai)
#pragma unroll
                for (int m = 0; m < 4; ++m) { const f32x4 v0 = acc[ai][bj][m][0], v1 = acc[ai][bj][m][1];
                    u32x4 w; w.x = cvt_pk_bf16(v0[0], v0[1]); w.y = cvt_pk_bf16(v0[2], v0[3]); w.z = cvt_pk_bf16(v1[0], v1[1]); w.w = cvt_pk_bf16(v1[2], v1[3]);
                    *(u32x4*)(hb + (size_t)(row0 + ai * HALF + m * 16) * 128) = w; } }
    }
};
__device__ __forceinline__ float silu_mul(float g, float u) { return g * __builtin_amdgcn_rcpf(1.0f + __builtin_amdgcn_exp2f(g * -1.4426950408889634f)) * u; }
struct EpiSwiGLU {
    static constexpr bool PERM = true, AFTER_DRAIN = false;
    bf16_t* O; int ldc; float sc;
    __device__ __forceinline__ void operator()(const f32x4 (&acc)[2][2][4][2], const Unit& u, int wr, int wc, int fr, int fq) const {
        const int row0 = u.pm * BM + wr * 64 + fr, col0 = u.pn * HALF + wc * 32 + 8 * fq;
#pragma unroll
        for (int ai = 0; ai < 2; ++ai)
#pragma unroll
            for (int m = 0; m < 4; ++m) { bf16_t* rowp = O + blk_off(row0 + ai * HALF + m * 16, col0, ldc);
                const f32x4 g0 = acc[ai][0][m][0] * sc, g1 = acc[ai][0][m][1] * sc, u0 = acc[ai][1][m][0] * sc, u1 = acc[ai][1][m][1] * sc;
                u32x4 w; w.x = cvt_pk_bf16(silu_mul(g0[0], u0[0]), silu_mul(g0[1], u0[1])); w.y = cvt_pk_bf16(silu_mul(g0[2], u0[2]), silu_mul(g0[3], u0[3]));
                w.z = cvt_pk_bf16(silu_mul(g1[0], u1[0]), silu_mul(g1[1], u1[1])); w.w = cvt_pk_bf16(silu_mul(g1[2], u1[2]), silu_mul(g1[3], u1[3]));
                *(u32x4*)rowp = w; }
    }
};
struct EpiRes {
    static constexpr bool PERM = false, AFTER_DRAIN = false;
    const float* R; float* Y; int ldc; float ra, sa;
    __device__ __forceinline__ void operator()(const f32x4 (&acc)[2][2][4][2], const Unit& u, int wr, int wc, int fr, int fq) const {
        const int row0 = u.pm * BM + wr * 64 + fr, col0 = u.pn * BM + wc * 32 + 4 * fq;
#pragma unroll
        for (int ai = 0; ai < 2; ++ai)
#pragma unroll
            for (int m = 0; m < 4; ++m) { const size_t off = (size_t)(row0 + ai * HALF + m * 16) * ldc + col0;
                f32x4 rv[2][2];
#pragma unroll
                for (int bj = 0; bj < 2; ++bj)
#pragma unroll
                    for (int n = 0; n < 2; ++n) rv[bj][n] = *(const f32x4*)(R + off + bj * HALF + n * 16);
#pragma unroll
                for (int bj = 0; bj < 2; ++bj)
#pragma unroll
                    for (int n = 0; n < 2; ++n) *(f32x4*)(Y + off + bj * HALF + n * 16) = rv[bj][n] * ra + acc[ai][bj][m][n] * sa;
                if (m & 1) asm volatile("" ::: "memory"); }
    }
};
constexpr float LNF_EPS = 1e-5f, LNF_INVD = 1.0f / 4096.0f;
constexpr int LNF_ROWS = 8192;
__device__ __forceinline__ void row_mu_rs(const float* st, int row, float& mu, float& rs) {
    const float s = st[row], q = st[LNF_ROWS + row]; mu = s * LNF_INVD; const float var = q * LNF_INVD - mu * mu; rs = __builtin_amdgcn_rsqf(fmaxf(var, 0.f) + LNF_EPS);
}
template <bool NORM, bool OUTB, bool STAT, int SA2  > struct EpiResN {
    static constexpr bool PERM = true, AFTER_DRAIN = false;
    static constexpr int ldc = 4096; static constexpr float ra = 1.18920711500272106671f  , sa = 0.5f * SA2;
    const float* R; float* Y; bf16_t* YB;
    const float* pst; const float* g; const float* b; float* ost;
    __device__ __forceinline__ void operator()(const f32x4 (&acc)[2][2][4][2], const Unit& u, int wr, int wc, int fr, int fq) const {
        const int row0 = u.pm * BM + wr * 64 + fr, col0 = u.pn * BM + wc * 32 + 8 * fq;
        f32x4 gv[2][2], bv[2][2]; float ssel = 0.f, qsel = 0.f; float mus[2][4], rss[2][4];
        if constexpr (NORM) {
#pragma unroll
            for (int bj = 0; bj < 2; ++bj)
#pragma unroll
                for (int n = 0; n < 2; ++n) { gv[bj][n] = *(const f32x4*)(g + col0 + bj * HALF + 4 * n); bv[bj][n] = *(const f32x4*)(b + col0 + bj * HALF + 4 * n); }
#pragma unroll
            for (int ai = 0; ai < 2; ++ai)
#pragma unroll
                for (int m = 0; m < 4; ++m) row_mu_rs(pst, row0 + ai * HALF + m * 16, mus[ai][m], rss[ai][m]);
        }
#pragma unroll
        for (int ai = 0; ai < 2; ++ai)
#pragma unroll
            for (int m = 0; m < 4; ++m) { const int row = row0 + ai * HALF + m * 16; const size_t off = (size_t)row * ldc + col0;
                float mu = 0.f, rs = 1.f; if constexpr (NORM) { mu = mus[ai][m]; rs = rss[ai][m]; }
                f32x4 rv[2][2];
#pragma unroll
                for (int bj = 0; bj < 2; ++bj)
#pragma unroll
                    for (int n = 0; n < 2; ++n) rv[bj][n] = *(const f32x4*)(R + off + bj * HALF + 4 * n);
                float s = 0.f, q = 0.f;
#pragma unroll
                for (int bj = 0; bj < 2; ++bj) { f32x4 y[2];
#pragma unroll
                    for (int n = 0; n < 2; ++n) { f32x4 r = rv[bj][n]; if constexpr (NORM) r = (r - mu) * rs * gv[bj][n] + bv[bj][n];
                        y[n] = r * ra + acc[ai][bj][m][n] * sa; *(f32x4*)(Y + off + bj * HALF + 4 * n) = y[n];
                        if constexpr (STAT) { s += (y[n][0] + y[n][1]) + (y[n][2] + y[n][3]); q += (y[n][0] * y[n][0] + y[n][1] * y[n][1]) + (y[n][2] * y[n][2] + y[n][3] * y[n][3]); } }
                    if constexpr (OUTB) { u32x4 w; w.x = cvt_pk_bf16(y[0][0], y[0][1]); w.y = cvt_pk_bf16(y[0][2], y[0][3]); w.z = cvt_pk_bf16(y[1][0], y[1][1]); w.w = cvt_pk_bf16(y[1][2], y[1][3]);
                        *(u32x4*)(YB + blk_off(row, col0 + bj * HALF, ldc)) = w; } }
                if constexpr (STAT) { s += __shfl_xor(s, 16); s += __shfl_xor(s, 32); q += __shfl_xor(q, 16); q += __shfl_xor(q, 32);
                    if (fq == m) { ssel = s; qsel = q; }
                    if (m == 3) { const int arow = row0 - fr + ai * HALF + fq * 16 + fr; unsafeAtomicAdd(ost + arow, ssel); unsafeAtomicAdd(ost + LNF_ROWS + arow, qsel); } }
                if (m & 1) asm volatile("" ::: "memory"); }
    }
};
struct EpiBf16HeadsN {
    static constexpr bool PERM = true, AFTER_DRAIN = false;
    bf16_t* O; int rows; const float* st; const float* c1; const float* c2;
    __device__ __forceinline__ void operator()(const f32x4 (&acc)[2][2][4][2], const Unit& u, int wr, int wc, int fr, int fq) const {
        const int row0 = u.pm * BM + wr * 64 + fr, col0 = wc * 32 + 8 * fq, colt = u.pn * BM + col0;
        f32x4 c1v[2][2], c2v[2][2];
#pragma unroll
        for (int bj = 0; bj < 2; ++bj)
#pragma unroll
            for (int n = 0; n < 2; ++n) { c1v[bj][n] = *(const f32x4*)(c1 + colt + bj * HALF + 4 * n); c2v[bj][n] = *(const f32x4*)(c2 + colt + bj * HALF + 4 * n); }
        float mus[2][4], rss[2][4];
#pragma unroll
        for (int ai = 0; ai < 2; ++ai)
#pragma unroll
            for (int m = 0; m < 4; ++m) row_mu_rs(st, row0 + ai * HALF + m * 16, mus[ai][m], rss[ai][m]);
#pragma unroll
        for (int ai = 0; ai < 2; ++ai)
#pragma unroll
            for (int m = 0; m < 4; ++m) { const int row = row0 + ai * HALF + m * 16; const float mu = mus[ai][m], rs = rss[ai][m];
#pragma unroll
                for (int bj = 0; bj < 2; ++bj) { const f32x4 v0 = (acc[ai][bj][m][0] - c1v[bj][0] * mu) * rs + c2v[bj][0], v1 = (acc[ai][bj][m][1] - c1v[bj][1] * mu) * rs + c2v[bj][1];
                    u32x4 w; w.x = cvt_pk_bf16(v0[0], v0[1]); w.y = cvt_pk_bf16(v0[2], v0[3]); w.z = cvt_pk_bf16(v1[0], v1[1]); w.w = cvt_pk_bf16(v1[2], v1[3]);
                    *(u32x4*)(O + ((size_t)(2 * u.pn + bj) * rows + row) * 128 + col0) = w; } }
    }
};
struct EpiSwiGLUN {
    static constexpr bool PERM = true, AFTER_DRAIN = false;
    bf16_t* O; int ldc; const float* st; const float* c1; const float* c2;
    __device__ __forceinline__ void operator()(const f32x4 (&acc)[2][2][4][2], const Unit& u, int wr, int wc, int fr, int fq) const {
        const int row0 = u.pm * BM + wr * 64 + fr, col0 = u.pn * HALF + wc * 32 + 8 * fq, colt = u.pn * BM + wc * 32 + 8 * fq;
        f32x4 c1v[2][2], c2v[2][2];
#pragma unroll
        for (int bj = 0; bj < 2; ++bj)
#pragma unroll
            for (int n = 0; n < 2; ++n) { c1v[bj][n] = *(const f32x4*)(c1 + colt + bj * HALF + 4 * n); c2v[bj][n] = *(const f32x4*)(c2 + colt + bj * HALF + 4 * n); }
        float mus[2][4], rss[2][4];
#pragma unroll
        for (int ai = 0; ai < 2; ++ai)
#pragma unroll
            for (int m = 0; m < 4; ++m) row_mu_rs(st, row0 + ai * HALF + m * 16, mus[ai][m], rss[ai][m]);
#pragma unroll
        for (int ai = 0; ai < 2; ++ai)
#pragma unroll
            for (int m = 0; m < 4; ++m) { const int row = row0 + ai * HALF + m * 16; const float mu = mus[ai][m], rs = rss[ai][m];
                const f32x4 g0 = (acc[ai][0][m][0] - c1v[0][0] * mu) * rs + c2v[0][0], g1 = (acc[ai][0][m][1] - c1v[0][1] * mu) * rs + c2v[0][1];
                const f32x4 u0 = (acc[ai][1][m][0] - c1v[1][0] * mu) * rs + c2v[1][0], u1 = (acc[ai][1][m][1] - c1v[1][1] * mu) * rs + c2v[1][1];
                u32x4 w; w.x = cvt_pk_bf16(silu_mul(g0[0], u0[0]), silu_mul(g0[1], u0[1])); w.y = cvt_pk_bf16(silu_mul(g0[2], u0[2]), silu_mul(g0[3], u0[3]));
                w.z = cvt_pk_bf16(silu_mul(g1[0], u1[0]), silu_mul(g1[1], u1[1])); w.w = cvt_pk_bf16(silu_mul(g1[2], u1[2]), silu_mul(g1[3], u1[3]));
                *(u32x4*)(O + blk_off(row, col0, ldc)) = w; }
    }
};

template <class Epi, class Sched, bool ALIGN_EPI = false, bool SP2 = false, int KREP = 1  , bool KBLK = false  >
__device__ __forceinline__ void gemm_phase(PG8_LAS unsigned char* lds, const Gemm g, const Sched& S, const Epi& E) {
    int tid_ = threadIdx.x; asm volatile("" : "+v"(tid_));
    const int tid = tid_, wid = __builtin_amdgcn_readfirstlane(tid >> 6), lane = tid & 63, wr = wid >> 2, wc = wid & 3, fr = lane & 15, fq = lane >> 4;
    const int K = g.K, nt = K / BK;
    unsigned voffA[2], voffB[2];
#pragma unroll
    for (int i = 0; i < 2; ++i) { int R, C; stage_rc(tid * 16 + i * 8192, R, C); const int Rb = Epi::PERM ? ((R & ~31) + perm32(R & 31)) : R;
        voffA[i] = (unsigned)(R * BK + C) * 2u; voffB[i] = (unsigned)(Rb * BK + C) * 2u; }
    const size_t kstep = (size_t)(BM * BK * 2);
    const size_t hstepA = (size_t)HALF * BK * 2, hstepB = hstepA;
    const size_t tstepA = (size_t)nt * kstep, tstepB = tstepA;
    const unsigned ldsw = (unsigned)wid * 1024u;
    const int aoff = lds_byte(wr * 64 + fr, fq * 8), boff = lds_byte(wc * 32 + fr, fq * 8);
#define PG8_SA(b, h) (((b) * 2 + (h)) * HTB)
#define PG8_SB(b, h) ((4 + (b) * 2 + (h)) * HTB)
#define PG8_STAGE(bufoff, gbase, voff) do { _Pragma("unroll") for (int _i = 0; _i < 2; ++_i) \
        __builtin_amdgcn_global_load_lds((const unsigned*)((const char*)(gbase) + (voff)[_i]), (PG8_LAS unsigned*)(lds + (bufoff) + ldsw + _i * 8192), 16, 0, 0); } while (0)
#define PG8_LDA(dst, b, h) do { _Pragma("unroll") for (int m = 0; m < 4; ++m) _Pragma("unroll") for (int k = 0; k < 2; ++k) dst[m][k] = *(const PG8_LAS bf16x8*)(lds + PG8_SA(b, h) + aoff + m * 2048 + k * 1024); } while (0)
#define PG8_LDB(dst, b, h) do { _Pragma("unroll") for (int n = 0; n < 2; ++n) _Pragma("unroll") for (int k = 0; k < 2; ++k) dst[n][k] = *(const PG8_LAS bf16x8*)(lds + PG8_SB(b, h) + boff + n * 2048 + k * 1024); } while (0)
#define PG8_MMA(ai, bj, At, Bt) do { _Pragma("unroll") for (int m = 0; m < 4; ++m) _Pragma("unroll") for (int n = 0; n < 2; ++n) _Pragma("unroll") for (int k = 0; k < 2; ++k) \
        acc[ai][bj][m][n] = __builtin_amdgcn_mfma_f32_16x16x32_bf16(Bt[n][k], At[m][k], acc[ai][bj][m][n], 0, 0, 0); } while (0)
#define PG8_WAIT_V(n) asm volatile("s_waitcnt vmcnt(" #n ")" ::: "memory")
#define PG8_WAIT_L(n) asm volatile("s_waitcnt lgkmcnt(" #n ")" ::: "memory")
#define PG8_BAR __builtin_amdgcn_s_barrier()
#define PG8_SCHED __builtin_amdgcn_sched_barrier(0)
    Unit cur, nxt; int ui = 0;
    if (!S.next(0, cur)) return;
    f32x4 acc[2][2][4][2];
#pragma unroll
    for (int a = 0; a < 2; ++a)
#pragma unroll
        for (int b = 0; b < 2; ++b)
#pragma unroll
            for (int m = 0; m < 4; ++m)
#pragma unroll
                for (int n = 0; n < 2; ++n) acc[a][b][m][n] = (f32x4){0.f, 0.f, 0.f, 0.f};
    bf16x8 At[4][2], B0[2][2], B1[2][2];
    const char* cA = (const char*)g.A + (size_t)cur.pm * tstepA; const char* cB = (const char*)g.Bt + (size_t)cur.pn * tstepB;
    S.a_ready(cur);
    if constexpr (SP2) {
        PG8_STAGE(PG8_SB(0, 0), cB, voffB); PG8_STAGE(PG8_SB(0, 1), cB + hstepB, voffB); PG8_STAGE(PG8_SA(0, 0), cA, voffA); PG8_STAGE(PG8_SA(0, 1), cA + hstepA, voffA);
        if (wr == 1) PG8_BAR;
        PG8_WAIT_V(2); PG8_BAR;
        PG8_STAGE(PG8_SB(1, 0), cB + kstep, voffB); PG8_STAGE(PG8_SA(1, 0), cA + kstep, voffA); PG8_STAGE(PG8_SB(1, 1), cB + hstepB + kstep, voffB);
        PG8_WAIT_V(6); PG8_BAR;
    } else {
        PG8_STAGE(PG8_SB(0, 0), cB, voffB); PG8_STAGE(PG8_SA(0, 0), cA, voffA); PG8_STAGE(PG8_SB(0, 1), cB + hstepB, voffB); PG8_STAGE(PG8_SA(0, 1), cA + hstepA, voffA);
        if (wr == 1) PG8_BAR;
        PG8_WAIT_V(4); PG8_BAR;
        PG8_STAGE(PG8_SB(1, 0), cB + kstep, voffB); PG8_STAGE(PG8_SA(1, 0), cA + kstep, voffA); PG8_STAGE(PG8_SB(1, 1), cB + hstepB + kstep, voffB);
        PG8_WAIT_V(6); PG8_BAR;
    }
    for (;;) {
        const bool has_next = S.next(ui + 1, nxt);
        const char* nA = has_next ? (const char*)g.A + (size_t)nxt.pm * tstepA : cA; const char* nB = has_next ? (const char*)g.Bt + (size_t)nxt.pn * tstepB : cB;
        for (int tt = 0; tt < nt * KREP; tt += 2) {
            const bool last = (tt == nt * KREP - 2);
            const int t = (KREP == 1) ? tt : (KBLK ? 4 * (tt / 8) + (tt % 4) : tt % nt), t2 = (KREP == 1) ? tt + 2 : (KBLK ? 4 * (((tt + 2) % (2 * nt)) / 8) + ((tt + 2) % 4) : (tt + 2) % nt);
            const char* a1 = cA + (size_t)(t + 1) * kstep;
            const char* a2 = last ? nA : cA + (size_t)t2 * kstep; const char* b2 = last ? nB : cB + (size_t)t2 * kstep;
            const char* a3 = a2 + kstep; const char* b3 = b2 + kstep;
            if (last && has_next) S.a_ready(nxt);
            if constexpr (SP2) {
            PG8_LDB(B0, 0, 0); PG8_LDB(B1, 0, 1); PG8_SCHED; PG8_LDA(At, 0, 0); PG8_STAGE(PG8_SA(1, 1), a1 + hstepA, voffA);
            PG8_WAIT_V(8); PG8_WAIT_L(0); __builtin_amdgcn_s_setprio(1); PG8_BAR; PG8_MMA(0, 0, At, B0); PG8_MMA(0, 1, At, B1); __builtin_amdgcn_s_setprio(0); PG8_BAR; PG8_SCHED;
            PG8_LDA(At, 0, 1); PG8_STAGE(PG8_SB(0, 0), b2, voffB); PG8_STAGE(PG8_SB(0, 1), b2 + hstepB, voffB); PG8_STAGE(PG8_SA(0, 0), a2, voffA);
            PG8_WAIT_V(8); PG8_WAIT_L(0); __builtin_amdgcn_s_setprio(1); PG8_BAR; PG8_MMA(1, 0, At, B0); PG8_MMA(1, 1, At, B1); __builtin_amdgcn_s_setprio(0); PG8_BAR; PG8_SCHED;
            PG8_LDB(B0, 1, 0); PG8_LDB(B1, 1, 1); PG8_SCHED; PG8_LDA(At, 1, 0); PG8_STAGE(PG8_SA(0, 1), a2 + hstepA, voffA);
            PG8_WAIT_V(8); PG8_WAIT_L(0); __builtin_amdgcn_s_setprio(1); PG8_BAR; PG8_MMA(0, 0, At, B0); PG8_MMA(0, 1, At, B1); __builtin_amdgcn_s_setprio(0); PG8_BAR; PG8_SCHED;
            PG8_LDA(At, 1, 1); PG8_STAGE(PG8_SB(1, 0), b3, voffB); PG8_STAGE(PG8_SB(1, 1), b3 + hstepB, voffB); PG8_STAGE(PG8_SA(1, 0), a3, voffA);
            PG8_WAIT_V(8); PG8_WAIT_L(0); __builtin_amdgcn_s_setprio(1); PG8_BAR; PG8_MMA(1, 0, At, B0); PG8_MMA(1, 1, At, B1); __builtin_amdgcn_s_setprio(0); PG8_BAR; PG8_SCHED;
            } else {
            PG8_LDB(B0, 0, 0); PG8_SCHED; PG8_LDA(At, 0, 0); PG8_STAGE(PG8_SA(1, 1), a1 + hstepA, voffA);
            PG8_WAIT_L(8); PG8_BAR; PG8_WAIT_L(0); PG8_MMA(0, 0, At, B0); PG8_BAR; PG8_SCHED;
            PG8_LDB(B1, 0, 1); PG8_STAGE(PG8_SB(0, 0), b2, voffB);
            PG8_BAR; PG8_WAIT_L(0); PG8_MMA(0, 1, At, B1); PG8_BAR;
            PG8_LDA(At, 0, 1); PG8_STAGE(PG8_SA(0, 0), a2, voffA);
            PG8_BAR; PG8_WAIT_L(0); PG8_MMA(1, 0, At, B0); PG8_BAR; PG8_SCHED;
            PG8_STAGE(PG8_SB(0, 1), b2 + hstepB, voffB);
            PG8_WAIT_V(6); PG8_BAR; PG8_MMA(1, 1, At, B1); PG8_BAR;
            PG8_LDB(B0, 1, 0); PG8_SCHED; PG8_LDA(At, 1, 0); PG8_STAGE(PG8_SA(0, 1), a2 + hstepA, voffA);
            PG8_WAIT_L(8); PG8_BAR; PG8_WAIT_L(0); PG8_MMA(0, 0, At, B0); PG8_BAR; PG8_SCHED;
            PG8_LDB(B1, 1, 1); PG8_STAGE(PG8_SB(1, 0), b3, voffB);
            PG8_BAR; PG8_WAIT_L(0); PG8_MMA(0, 1, At, B1); PG8_BAR;
            PG8_LDA(At, 1, 1); PG8_STAGE(PG8_SA(1, 0), a3, voffA);
            PG8_BAR; PG8_WAIT_L(0); PG8_MMA(1, 0, At, B0); PG8_BAR; PG8_SCHED;
            PG8_STAGE(PG8_SB(1, 1), b3 + hstepB, voffB);
            PG8_WAIT_V(6); PG8_BAR; PG8_MMA(1, 1, At, B1); PG8_BAR;
            }
        }
        if constexpr (ALIGN_EPI) { if (wr == 0) PG8_BAR; }
        if constexpr (!Epi::AFTER_DRAIN) { E(acc, cur, wr, wc, fr, fq); S.done(cur); }
        if (!has_next) break;
#pragma unroll
        for (int a = 0; a < 2; ++a)
#pragma unroll
            for (int b = 0; b < 2; ++b)
#pragma unroll
                for (int m = 0; m < 4; ++m)
#pragma unroll
                    for (int n = 0; n < 2; ++n) acc[a][b][m][n] = (f32x4){0.f, 0.f, 0.f, 0.f};
        cur = nxt; cA = nA; cB = nB; ++ui;
        if constexpr (ALIGN_EPI) { if (wr == 1) PG8_BAR; }
    }
    PG8_WAIT_V(0);
    if constexpr (!ALIGN_EPI) { if (wr == 0) PG8_BAR; }
    PG8_BAR;
    if constexpr (Epi::AFTER_DRAIN) { E.fused(acc, cur, wr, wc, fr, fq, lds, wid, lane); S.done(cur); }
#undef PG8_SA
#undef PG8_SB
#undef PG8_STAGE
#undef PG8_LDA
#undef PG8_LDB
#undef PG8_MMA
#undef PG8_WAIT_V
#undef PG8_WAIT_L
#undef PG8_BAR
#undef PG8_SCHED
}
}
namespace att {
typedef unsigned short bf16_t;
using bf16x8 = __attribute__((ext_vector_type(8))) short;
using s16x4  = __attribute__((ext_vector_type(4))) short;
using f32x16 = __attribute__((ext_vector_type(16))) float;
using u32x4  = __attribute__((ext_vector_type(4))) unsigned;
constexpr int   D = 128, NW = 8, QBLK = 32, KVBLK = 64;
constexpr float SCALE = 0.088388347648318440f, LOG2E = 1.4426950408889634f;
constexpr float THR = 8.f;
constexpr int LDQ = 128, LDK = 128;
constexpr int SHM_V = KVBLK * D * 2, SHM_K = KVBLK * D * 2;
constexpr int OFF_WS = 2 * SHM_V + 2 * SHM_K, OFF_TB = OFF_WS + NW * 64 * 4, TBN = 2560, TB0 = 1280, SHM_ATTN = OFF_TB + TBN * 4;
#define KSWZ(row, colB) ((row) * 256 + ((colB) ^ (((row) & 7) << 4)))
#define SBAR() __builtin_amdgcn_sched_barrier(0)
__device__ __forceinline__ int crow(int r, int hi) { return (r & 3) + 8 * (r >> 2) + 4 * hi; }
__device__ __forceinline__ unsigned cvtpk(float lo, float hi) { unsigned r; asm volatile("v_cvt_pk_bf16_f32 %0, %1, %2" : "=v"(r) : "v"(lo), "v"(hi)); return r; }
__device__ __forceinline__ void partialSM_fix(f32x16& p0, f32x16& p1) {
#pragma unroll
  for (int r = 0; r < 16; ++r) p0[r] = __builtin_amdgcn_exp2f(p0[r]);
}
__device__ __forceinline__ void partialSM_b(f32x16& p0, f32x16& p1, float& m_reg, float& mn, float& alpha, const float* tbp) {
  constexpr float C = SCALE * LOG2E;
#pragma unroll
  for (int r = 0; r < 16; ++r) { const int o = (r & 3) + 8 * (r >> 2); p0[r] = fmaf(p0[r], C, tbp[o]); p1[r] = fmaf(p1[r], C, tbp[32 + o]); }
  float pmax = p0[0];
#pragma unroll
  for (int r = 1; r < 16; ++r) pmax = fmaxf(pmax, p0[r]);
#pragma unroll
  for (int r = 0; r < 16; ++r) pmax = fmaxf(pmax, p1[r]);
  { auto rr = __builtin_amdgcn_permlane32_swap(__float_as_uint(pmax), __float_as_uint(pmax), false, false);
    pmax = fmaxf(__uint_as_float(rr[0]), __uint_as_float(rr[1])); }
  if (__builtin_expect(__all(pmax - m_reg <= THR * LOG2E), 1)) { mn = m_reg; alpha = 1.f; }
  else { mn = fmaxf(m_reg, pmax); alpha = __builtin_amdgcn_exp2f(m_reg - mn); m_reg = mn; }
#pragma unroll
  for (int r = 0; r < 16; ++r) p0[r] = p0[r] - mn;
#pragma unroll
  for (int r = 0; r < 16; ++r) p1[r] = p1[r] - mn;
#pragma unroll
  for (int r = 0; r < 16; ++r) p0[r] = __builtin_amdgcn_exp2f(p0[r]);
}
__device__ __forceinline__ void finishSM(f32x16& p0, f32x16& p1, float alpha, float& l_reg, bf16x8& pa0, bf16x8& pa1, bf16x8& pa2, bf16x8& pa3) {
#pragma unroll
  for (int r = 0; r < 16; ++r) p1[r] = __builtin_amdgcn_exp2f(p1[r]);
  float ps = 0;
#pragma unroll
  for (int r = 0; r < 16; ++r) ps += p0[r];
#pragma unroll
  for (int r = 0; r < 16; ++r) ps += p1[r];
  { auto rr = __builtin_amdgcn_permlane32_swap(__float_as_uint(ps), __float_as_uint(ps), false, false);
    ps = __uint_as_float(rr[0]) + __uint_as_float(rr[1]); }
  l_reg = l_reg * alpha + ps;
#define PK4(P, BASE, OUT) do { unsigned a0 = cvtpk(P[BASE + 0], P[BASE + 1]), a1 = cvtpk(P[BASE + 2], P[BASE + 3]);   \
    unsigned b0 = cvtpk(P[BASE + 4], P[BASE + 5]), b1 = cvtpk(P[BASE + 6], P[BASE + 7]);                              \
    auto r0 = __builtin_amdgcn_permlane32_swap(a0, b0, false, false); auto r1 = __builtin_amdgcn_permlane32_swap(a1, b1, false, false); \
    u32x4 w = {r0[0], r1[0], r0[1], r1[1]}; OUT = *reinterpret_cast<bf16x8*>(&w); } while (0)
  PK4(p0, 0, pa0); PK4(p0, 8, pa1); PK4(p1, 0, pa2); PK4(p1, 8, pa3);
#undef PK4
}
__device__ __forceinline__ void qkt(f32x16& p0, f32x16& p1, const char* Ks, const bf16x8* qr, int r32, int hi) {
  p0 = f32x16{}; p1 = f32x16{};
#pragma unroll
  for (int d0 = 0; d0 < 8; ++d0) { const int cb = (d0 * 16 + hi * 8) * 2;
    const bf16x8 b0 = *reinterpret_cast<const bf16x8*>(Ks + KSWZ(r32, cb));
    const bf16x8 b1 = *reinterpret_cast<const bf16x8*>(Ks + KSWZ(32 + r32, cb));
    p0 = __builtin_amdgcn_mfma_f32_32x32x16_bf16(b0, qr[d0], p0, 0, 0, 0);
    p1 = __builtin_amdgcn_mfma_f32_32x32x16_bf16(b1, qr[d0], p1, 0, 0, 0); }
}
__device__ __forceinline__ int v_st(int k, int c) { const int kk = (k & ~0xC) | ((k & 4) << 1) | ((k & 8) >> 1); return ((kk >> 3) * 4 + (c >> 5)) * 512 + ((kk & 7) * 32 + (c & 31)) * 2; }
__device__ __forceinline__ int v_rd_base(int lane) { return ((lane & 3) << 3) | (((lane >> 2) & 3) << 6) | (((lane >> 4) & 1) << 5) | (((lane >> 5) & 1) << 8); }
constexpr int v_rd_off(int d0, int ks, int half) { return d0 * 512 + ks * 4096 + half * 2048; }
template <int OFF> __device__ __forceinline__ s16x4 tr_read(int vb) {
  s16x4 r; asm volatile("ds_read_b64_tr_b16 %0, %1 offset:%2" : "=&v"(r) : "v"(vb), "i"(OFF) : "memory"); return r;
}
template <int D0> __device__ __forceinline__ void pv_one(f32x16& od, int vb, bf16x8 pa0, bf16x8 pa1, bf16x8 pa2, bf16x8 pa3) {
  const s16x4 l0 = tr_read<v_rd_off(D0, 0, 0)>(vb), h0 = tr_read<v_rd_off(D0, 0, 1)>(vb), l1 = tr_read<v_rd_off(D0, 1, 0)>(vb), h1 = tr_read<v_rd_off(D0, 1, 1)>(vb);
  const s16x4 l2 = tr_read<v_rd_off(D0, 2, 0)>(vb), h2 = tr_read<v_rd_off(D0, 2, 1)>(vb), l3 = tr_read<v_rd_off(D0, 3, 0)>(vb), h3 = tr_read<v_rd_off(D0, 3, 1)>(vb);
  asm volatile("s_waitcnt lgkmcnt(0)" ::: "memory"); SBAR();
#define PK(L, H) (bf16x8){L[0], L[1], L[2], L[3], H[0], H[1], H[2], H[3]}
  od = __builtin_amdgcn_mfma_f32_32x32x16_bf16(pa0, PK(l0, h0), od, 0, 0, 0);
  od = __builtin_amdgcn_mfma_f32_32x32x16_bf16(pa1, PK(l1, h1), od, 0, 0, 0);
  od = __builtin_amdgcn_mfma_f32_32x32x16_bf16(pa2, PK(l2, h2), od, 0, 0, 0);
  od = __builtin_amdgcn_mfma_f32_32x32x16_bf16(pa3, PK(l3, h3), od, 0, 0, 0);
#undef PK
}
__device__ __forceinline__ void pv_d0(f32x16* o, int vb, bf16x8 pa0, bf16x8 pa1, bf16x8 pa2, bf16x8 pa3) {
  pv_one<0>(o[0], vb, pa0, pa1, pa2, pa3); pv_one<1>(o[1], vb, pa0, pa1, pa2, pa3); pv_one<2>(o[2], vb, pa0, pa1, pa2, pa3); pv_one<3>(o[3], vb, pa0, pa1, pa2, pa3);
}
template <bool BIAS, int SDEPTH, bool FIXM = false>
__device__ __forceinline__ void attn_body(const bf16_t* __restrict__ Qb, const bf16_t* __restrict__ Kh, const bf16_t* __restrict__ Vh, bf16_t* __restrict__ Ob, int NT, int koff, char* lds, int tstep = KVBLK) {
  int tid_ = threadIdx.x; asm volatile("" : "+v"(tid_));
  const int tid = tid_, wid = tid >> 6, lane = tid & 63, r32 = lane & 31, hi = lane >> 5;
  char* V_lds = lds; char* K_lds = lds + 2 * SHM_V;
  float* ws = (float*)(lds + OFF_WS) + wid * 64; float* li_l = ws; float* al_l = ws + 32;
  const float* tb0 = (const float*)(lds + OFF_TB) + (koff + TB0 - (wid * QBLK + r32) + 4 * hi);
  float m_reg = -1e30f, l_reg = 0; f32x16 o[4] = {}; bf16x8 qr[8];
  const bf16_t* Qw = Qb + (long)(wid * QBLK + r32) * LDQ + hi * 8;
#pragma unroll
  for (int d0 = 0; d0 < 8; ++d0) qr[d0] = *reinterpret_cast<const bf16x8*>(Qw + d0 * 16);
  const int sr = tid >> 4, sc = (tid & 15) * 8, vst0 = v_st(sr, sc), vst1 = v_st(32 + sr, sc);
  const int vb0 = (int)(uintptr_t)V_lds + v_rd_base(lane);
  struct { bf16x8 vs0, vs1, ks0, ks1; } sr_[SDEPTH];
#define SLOAD(i, k0) do { sr_[i].vs0 = *reinterpret_cast<const bf16x8*>(&Vh[(long)((k0) + sr) * LDK + sc]); sr_[i].vs1 = *reinterpret_cast<const bf16x8*>(&Vh[(long)((k0) + 32 + sr) * LDK + sc]); \
    sr_[i].ks0 = *reinterpret_cast<const bf16x8*>(&Kh[(long)((k0) + sr) * LDK + sc]); sr_[i].ks1 = *reinterpret_cast<const bf16x8*>(&Kh[(long)((k0) + 32 + sr) * LDK + sc]); } while (0)
#define SWRITE(b, i) do { *(bf16x8*)(V_lds + (b) * SHM_V + vst0) = sr_[i].vs0;          \
    *(bf16x8*)(V_lds + (b) * SHM_V + vst1) = sr_[i].vs1; const int kc = sc * 2;               \
    *(bf16x8*)(K_lds + (b) * SHM_K + KSWZ(sr, kc)) = sr_[i].ks0;                       \
    *(bf16x8*)(K_lds + (b) * SHM_K + KSWZ(32 + sr, kc)) = sr_[i].ks1; } while (0)
#define SWAIT() do { if constexpr (SDEPTH == 2) asm volatile("s_waitcnt vmcnt(4)" ::: "memory"); else asm volatile("s_waitcnt vmcnt(0)" ::: "memory"); } while (0)
#define RESC(a) do { if constexpr (!FIXM) if (__any((a) < 1.f)) { if (hi == 0) al_l[r32] = (a); asm volatile("s_waitcnt lgkmcnt(0)" ::: "memory"); \
    _Pragma("unroll") for (int d = 0; d < 4; ++d) _Pragma("unroll") for (int r = 0; r < 16; ++r) o[d][r] *= al_l[crow(r, hi)]; } } while (0)
#define PSM(P0, P1, MN, AL, t) do { if constexpr (BIAS) partialSM_b(P0, P1, m_reg, MN, AL, tb0 + (t) * tstep); else { static_assert(BIAS || FIXM, "mixer A: fixed reference, or the BIAS body with a zero table"); partialSM_fix(P0, P1); AL = 1.f; } } while (0)
  f32x16 pA0, pA1, pB0, pB1; float mnA, mnB, alA, alB; bf16x8 pa0, pa1, pa2, pa3;
  constexpr int SE = 0, SO = SDEPTH - 1;
  SLOAD(SE, 0); asm volatile("s_waitcnt vmcnt(0)" ::: "memory"); SWRITE(0, SE); __syncthreads();
  qkt(pA0, pA1, K_lds, qr, r32, hi); PSM(pA0, pA1, mnA, alA, 0);
  SLOAD(SO, KVBLK); if constexpr (SDEPTH == 2) { if (2 < NT) SLOAD(SE, 2 * KVBLK); }
  SWAIT(); SWRITE(1, SO); __syncthreads();
  for (int j = 1; j + 1 < NT; j += 2) {
    SBAR(); qkt(pB0, pB1, K_lds + SHM_K, qr, r32, hi);
    finishSM(pA0, pA1, alA, l_reg, pa0, pa1, pa2, pa3); SBAR();
    SLOAD(SO, (j + SDEPTH) * KVBLK); SBAR();
    pv_d0(o, vb0, pa0, pa1, pa2, pa3); PSM(pB0, pB1, mnB, alB, j);
    __syncthreads(); SWAIT(); SWRITE(0, SE);
    RESC(alB); __syncthreads();
    SBAR(); qkt(pA0, pA1, K_lds, qr, r32, hi);
    finishSM(pB0, pB1, alB, l_reg, pa0, pa1, pa2, pa3); SBAR();
    if (SDEPTH == 1 || j + 3 < NT) SLOAD(SE, (j + 1 + SDEPTH) * KVBLK); SBAR();
    pv_d0(o, vb0 + SHM_V, pa0, pa1, pa2, pa3); PSM(pA0, pA1, mnA, alA, j + 1);
    __syncthreads(); SWAIT(); SWRITE(1, SO);
    RESC(alA); __syncthreads();
  }
  SBAR(); qkt(pB0, pB1, K_lds + SHM_K, qr, r32, hi);
  finishSM(pA0, pA1, alA, l_reg, pa0, pa1, pa2, pa3); SBAR();
  pv_d0(o, vb0, pa0, pa1, pa2, pa3); PSM(pB0, pB1, mnB, alB, NT - 1);
  __syncthreads(); RESC(alB);
  finishSM(pB0, pB1, alB, l_reg, pa0, pa1, pa2, pa3); SBAR();
  pv_d0(o, vb0 + SHM_V, pa0, pa1, pa2, pa3);
  if (hi == 0) li_l[r32] = l_reg; asm volatile("s_waitcnt lgkmcnt(0)" ::: "memory");
  float rli[16];
#pragma unroll
  for (int r = 0; r < 16; ++r) rli[r] = __builtin_amdgcn_rcpf(li_l[crow(r, hi)]);
  __syncthreads();
  { bf16_t* stg = (bf16_t*)(lds + wid * (QBLK * D * 2));
#pragma unroll
    for (int r = 0; r < 16; ++r) { const int orow = crow(r, hi);
#pragma unroll
      for (int d0 = 0; d0 < 4; ++d0) stg[orow * D + d0 * 32 + r32] = (bf16_t)(cvtpk(o[d0][r] * rli[r], 0.f) & 0xffffu); }
    asm volatile("s_waitcnt lgkmcnt(0)" ::: "memory");
    bf16_t* Ow = Ob + (long)(wid * QBLK) * 64;
#pragma unroll
    for (int i = 0; i < 8; ++i) { const int row = 4 * i + (lane >> 4), ch = lane & 15;
      const u32x4 v = *(const u32x4*)(stg + row * D + ch * 8);
      *(u32x4*)(Ow + (ch >> 3) * (256 * 64) + row * 64 + (ch & 7) * 8) = v; } }
  __syncthreads();
#undef SLOAD
#undef SWRITE
#undef SWAIT
#undef RESC
#undef PSM
}
#undef KSWZ
#undef SBAR
}

#define GAS __attribute__((address_space(1)))
#define LAS __attribute__((address_space(3)))
typedef unsigned short bf16;
typedef unsigned v4u __attribute__((ext_vector_type(4)));
typedef float f32x4 __attribute__((ext_vector_type(4)));
typedef short bf16x8 __attribute__((ext_vector_type(8)));
typedef GAS unsigned gu32;
typedef GAS unsigned long long gu64;
#define RLX_AGENT __ATOMIC_RELAXED, __HIP_MEMORY_SCOPE_AGENT
#define LDS_WAIT() asm volatile("s_waitcnt lgkmcnt(0)" ::: "memory")
#define VM_WAIT() asm volatile("s_waitcnt vmcnt(0)" ::: "memory")
__device__ __forceinline__ unsigned long long rt() { return __builtin_amdgcn_s_memrealtime(); }
__device__ __forceinline__ unsigned f2bf(float f) { unsigned u = __builtin_bit_cast(unsigned, f); return (u + 0x7fffu + ((u >> 16) & 1u)) >> 16; }
__device__ __forceinline__ unsigned pk2(float lo, float hi) { return f2bf(lo) | (f2bf(hi) << 16); }

#define XB_TMO      128
#define XB_XCNT(j)  (256  + 64 * (j))
#define XB_XSUB(j)  (1280 + 64 * (j))
#define XB_XGEN(j)  (2304 + 64 * (j))
#define XB_TOP      3328
#define XB_TOPGEN   3392
#define XCD_BAR_WORDS 3456
#define XB_SPIN_CAP (1u << 18)

__device__ __forceinline__ unsigned xb_ld(unsigned* p)              { return __hip_atomic_load(p, __ATOMIC_RELAXED, __HIP_MEMORY_SCOPE_AGENT); }
__device__ __forceinline__ unsigned xb_add(unsigned* p, unsigned v) { return __hip_atomic_fetch_add(p, v, __ATOMIC_RELAXED, __HIP_MEMORY_SCOPE_AGENT); }
__device__ __forceinline__ unsigned xb_xcc_id() { return (unsigned)__builtin_amdgcn_s_getreg((3 << 11) | 20) & 0xFu; }
#define XB_SPIN(cond, bar) do { unsigned _sp = 0; while (cond) { __builtin_amdgcn_s_sleep(1); \
    if ((++_sp & 255u) == 0u) { if (xb_ld(&(bar)[XB_TMO])) break; if (_sp > XB_SPIN_CAP) { atomicAdd(&(bar)[XB_TMO], 1u); break; } } } } while (0)

struct XcdBarrier {
    unsigned* bar; unsigned x;
    volatile LAS unsigned* st;
};

__device__ __forceinline__ XcdBarrier xcd_barrier_post(unsigned* bar, volatile LAS unsigned* st) {
    XcdBarrier b; b.bar = bar; b.x = xb_xcc_id(); b.st = st;
    if (threadIdx.x == 0) (void)xb_add(&bar[XB_XCNT(b.x)], 1u);
    return b;
}
__device__ __forceinline__ void xcd_barrier_complete(unsigned* bar, unsigned x, unsigned& nloc, unsigned& nx) {
    const unsigned G = gridDim.x * gridDim.y * gridDim.z;
    unsigned sum, cnt, mine, sp = 0u;
    for (;;) {
        sum = 0u; cnt = 0u; mine = 0u;
#pragma unroll
        for (unsigned j = 0; j < 16; ++j) { const unsigned c = xb_ld(&bar[XB_XCNT(j)]); sum += c; cnt += (c > 0u) ? 1u : 0u; mine = (j == x) ? c : mine; }
        if (sum == G) break;
        __builtin_amdgcn_s_sleep(1);
        if ((++sp & 255u) == 0u) { if (xb_ld(&bar[XB_TMO])) break; if (sp > XB_SPIN_CAP) { atomicAdd(&bar[XB_TMO], 1u); break; } }
    }
    nloc = mine > 0u ? mine : 1u; nx = cnt > 0u ? cnt : 1u;
}

__device__ __forceinline__ void xcd_barrier(const XcdBarrier& b) {
    asm volatile("s_waitcnt vmcnt(0)" ::: "memory");
    __syncthreads();
    if (threadIdx.x == 0) {
        unsigned* bar = b.bar;
        __builtin_amdgcn_s_waitcnt(0);
        unsigned nloc = b.st[0], nx = b.st[1];
        if (nloc == 0u) { xcd_barrier_complete(bar, b.x, nloc, nx); b.st[0] = nloc; b.st[1] = nx; }
        const unsigned old = xb_add(&bar[XB_XSUB(b.x)], 1u);
        const unsigned gen = old / nloc;
        if (old + 1u == (gen + 1u) * nloc) {
            __builtin_amdgcn_fence(__ATOMIC_RELEASE, "agent");
            asm volatile("s_waitcnt vmcnt(0)" ::: "memory");
            const unsigned og = xb_add(&bar[XB_TOP], 1u);
            const unsigned tg = og / nx;
            if (og + 1u == (tg + 1u) * nx) xb_add(&bar[XB_TOPGEN], 1u);
            else XB_SPIN(xb_ld(&bar[XB_TOPGEN]) == tg, bar);
            __builtin_amdgcn_fence(__ATOMIC_ACQUIRE, "agent");
            xb_add(&bar[XB_XGEN(b.x)], 1u);
            asm volatile("s_waitcnt vmcnt(0)" ::: "memory");
        } else {
            XB_SPIN(xb_ld(&bar[XB_XGEN(b.x)]) == gen, bar);
            __builtin_amdgcn_fence(__ATOMIC_ACQUIRE, "agent");
            asm volatile("s_waitcnt vmcnt(0)" ::: "memory");
        }
    }
    __syncthreads();
}

constexpr int NWAVES = 8;
constexpr int SEQ = 8192, DM = 4096, FF = 11008, NGU = 2 * FF, NIN = 9216;
constexpr int KP = DM + PADK, FP = FF + PADF;
constexpr int HQA = 0, HKA = 16, HVA = 20, HQB = 24, HKB = 40, HVB = 56;
constexpr float ALPHA = 1.18920711500272106671f;
constexpr float LN_EPS = 1e-5f, RMS_EPS = 1e-6f;
constexpr size_t MiB = 1u << 20;
constexpr size_t WS_CTL = 0, CTL_ZERO_BYTES = 512 * 1024;
constexpr size_t WS_STAT = 64 * 1024;
constexpr size_t WS_CV = WS_STAT + (size_t)2 * SEQ * 2 * 4;
static_assert(WS_CV + (size_t)(2 * NIN + 2 * NGU) * 4 <= CTL_ZERO_BYTES, "zeroed region");
constexpr size_t WS_ROPE = 1 * MiB;
constexpr size_t WS_TB = 1 * MiB + 64 * 1024;
constexpr size_t rup(size_t b) { return (b + MiB - 1) / MiB * MiB; }
constexpr size_t WS_WGU1 = 2 * MiB, WS_WD1 = WS_WGU1 + rup((size_t)NGU * KP * 2), WS_WIN = WS_WD1 + rup((size_t)DM * FP * 2), WS_WOUT = WS_WIN + rup((size_t)NIN * KP * 2),
                 WS_WGU2 = WS_WOUT + rup((size_t)DM * KP * 2), WS_WD2 = WS_WGU2 + rup((size_t)NGU * KP * 2);
constexpr size_t WS_XB = WS_WD2 + rup((size_t)DM * FP * 2);
constexpr size_t WS_ACT = WS_XB + rup((size_t)SEQ * KP * 2);
constexpr size_t WS_Y = WS_ACT + rup((size_t)SEQ * FP * 2);
constexpr size_t WS_HB = WS_Y + rup((size_t)SEQ * DM * 4);
constexpr size_t WS_END = WS_HB + rup((size_t)SEQ * KP * 2);
static_assert((size_t)SEQ * NIN * 2 <= (size_t)SEQ * FP * 2, "the projection fits the activation buffer");
constexpr int CW_BAR = 4096;
constexpr int RING_OFF = 0, RING_BYTES = 131072;
constexpr int P0_SCR_PER_WAVE = 64 * 65 * 4;
constexpr int LDSCTL_OFF = 143360;
constexpr int LDS_BYTES = 147456;
static_assert(NWAVES * P0_SCR_PER_WAVE <= LDSCTL_OFF && att::SHM_ATTN <= RING_BYTES && LDSCTL_OFF + 64 <= LDS_BYTES, "LDS map");

__device__ __forceinline__ float wave_sum(float v) {
#pragma unroll
    for (int o = 1; o < 64; o <<= 1) v += __shfl_xor(v, o);
    return v;
}
struct P0Item { const float* src; bf16* dst; int N, K; const float* g; const float* b; float* c1; float* c2; };
__device__ __forceinline__ P0Item p0_item(const float* W, int K, int N, bf16* WT, bool gu, int half, int item, const float* g = nullptr, const float* b = nullptr, float* c1 = nullptr, float* c2 = nullptr) {
    const int nblk = N / 64, kb = item / nblk, nb = item - kb * nblk, k0 = 64 * kb, n0 = 64 * nb;
    const int drow0 = gu ? ((n0 >> 7) << 8) + (n0 & 127) + 128 * half : n0;
    P0Item r; r.src = W + (size_t)k0 * N + n0; r.dst = WT + pg8::blk_off(drow0, k0, K); r.N = N; r.K = 64;
    r.g = g ? g + k0 : nullptr; r.b = g ? b + k0 : nullptr; r.c1 = g ? c1 + drow0 : nullptr; r.c2 = g ? c2 + drow0 : nullptr; return r;
}
__device__ __forceinline__ void p0_load(f32x4 (&v)[16], const P0Item& it, int lane) {
    const unsigned lo = (unsigned)(lane >> 4) * (unsigned)it.N + 4u * (unsigned)(lane & 15);
#pragma unroll
    for (int i = 0; i < 16; ++i) v[i] = __builtin_nontemporal_load((const f32x4*)(it.src + (size_t)(4 * i) * it.N + lo));
}
__device__ __forceinline__ unsigned p0_cvtpk(float lo, float hi) { unsigned r; asm volatile("v_cvt_pk_bf16_f32 %0, %1, %2" : "=v"(r) : "v"(lo), "v"(hi)); return r; }
template <bool NTS> __device__ __forceinline__ void p0_store(const f32x4 (&v)[16], const P0Item& it, LAS float* scr, int lane) {
    LAS float* w = scr + (lane >> 4) * 65 + 4 * (lane & 15);
#pragma unroll
    for (int i = 0; i < 16; ++i) { w[i * 260 + 0] = v[i].x; w[i * 260 + 1] = v[i].y; w[i * 260 + 2] = v[i].z; w[i * 260 + 3] = v[i].w; }
    LDS_WAIT(); asm volatile("" ::: "memory");
    const int c = lane & 7;
    const bool fold = it.g != nullptr;
    f32x4 g0 = {1.f, 1.f, 1.f, 1.f}, g1 = g0, b0 = {0.f, 0.f, 0.f, 0.f}, b1 = b0;
    if (fold) { g0 = *(const f32x4*)(it.g + 8 * c); g1 = *(const f32x4*)(it.g + 8 * c + 4); b0 = *(const f32x4*)(it.b + 8 * c); b1 = *(const f32x4*)(it.b + 8 * c + 4); }
    float a1[8], a2[8];
#pragma unroll
    for (int j = 0; j < 8; ++j) { const int n = (lane >> 3) + 8 * j; const LAS float* s = scr + (8 * c) * 65 + n;
        const float w0 = s[0 * 65], w1 = s[1 * 65], w2 = s[2 * 65], w3 = s[3 * 65], w4 = s[4 * 65], w5 = s[5 * 65], w6 = s[6 * 65], w7 = s[7 * 65];
        v4u o; o.x = p0_cvtpk(w0 * g0.x, w1 * g0.y); o.y = p0_cvtpk(w2 * g0.z, w3 * g0.w); o.z = p0_cvtpk(w4 * g1.x, w5 * g1.y); o.w = p0_cvtpk(w6 * g1.z, w7 * g1.w);
        if (NTS) __builtin_nontemporal_store(o, (GAS v4u*)(it.dst + (size_t)n * it.K + 8 * c)); else *(GAS v4u*)(it.dst + (size_t)n * it.K + 8 * c) = o;
        if (fold) {
            float p1 = (w0 * g0.x + w1 * g0.y) + (w2 * g0.z + w3 * g0.w) + (w4 * g1.x + w5 * g1.y) + (w6 * g1.z + w7 * g1.w);
            float p2 = (w0 * b0.x + w1 * b0.y) + (w2 * b0.z + w3 * b0.w) + (w4 * b1.x + w5 * b1.y) + (w6 * b1.z + w7 * b1.w);
            p1 += __shfl_xor(p1, 1); p1 += __shfl_xor(p1, 2); p1 += __shfl_xor(p1, 4); p2 += __shfl_xor(p2, 1); p2 += __shfl_xor(p2, 2); p2 += __shfl_xor(p2, 4);
            a1[j] = p1; a2[j] = p2; } }
    LDS_WAIT(); asm volatile("" ::: "memory");
    if (fold) {
        if (c == 0) {
#pragma unroll
            for (int j = 0; j < 8; ++j) { scr[(lane >> 3) + 8 * j] = a1[j]; scr[64 + (lane >> 3) + 8 * j] = a2[j]; } }
        LDS_WAIT(); asm volatile("" ::: "memory");
        const float v1 = scr[lane], v2 = scr[64 + lane];
        LDS_WAIT(); asm volatile("" ::: "memory");
        unsafeAtomicAdd(it.c1 + lane, v1); unsafeAtomicAdd(it.c2 + lane, v2);
    }
}
__device__ __forceinline__ int t5_bucket(int rel) {
    const int nb = 16, max_exact = 8; const int ret = rel > 0 ? nb : 0; const int n = rel < 0 ? -rel : rel;
    int large = max_exact + (int)(log((double)(n < 1 ? 1 : n) / (double)max_exact) / log(1024.0 / (double)max_exact) * (double)(nb - max_exact));
    large = large < nb - 1 ? large : nb - 1;
    return ret + (n < max_exact ? n : large);
}
__device__ __forceinline__ void ln_rows2(const float* __restrict__ y0, const float* __restrict__ y1, const float* __restrict__ g, const float* __restrict__ b, float* __restrict__ o0, float* __restrict__ o1, int lane) {
    const GAS f32x4* r0 = (const GAS f32x4*)y0 + lane; const GAS f32x4* r1 = (const GAS f32x4*)y1 + lane;
    f32x4 v[16], w[16]; float s = 0.f, t = 0.f;
#pragma unroll
    for (int j = 0; j < 16; ++j) v[j] = __builtin_nontemporal_load(r0 + 64 * j);
#pragma unroll
    for (int j = 0; j < 16; ++j) w[j] = __builtin_nontemporal_load(r1 + 64 * j);
#pragma unroll
    for (int j = 0; j < 16; ++j) { s += (v[j].x + v[j].y) + (v[j].z + v[j].w); t += (w[j].x + w[j].y) + (w[j].z + w[j].w); }
    const float m0 = wave_sum(s) * (1.f / DM), m1 = wave_sum(t) * (1.f / DM); float s2 = 0.f, t2 = 0.f;
#pragma unroll
    for (int j = 0; j < 16; ++j) { v[j] = v[j] - m0; w[j] = w[j] - m1; s2 += (v[j].x * v[j].x + v[j].y * v[j].y) + (v[j].z * v[j].z + v[j].w * v[j].w); t2 += (w[j].x * w[j].x + w[j].y * w[j].y) + (w[j].z * w[j].z + w[j].w * w[j].w); }
    const float rs0 = 1.f / sqrtf(wave_sum(s2) * (1.f / DM) + LN_EPS), rs1 = 1.f / sqrtf(wave_sum(t2) * (1.f / DM) + LN_EPS);
    const GAS f32x4* gr = (const GAS f32x4*)g + lane; const GAS f32x4* br = (const GAS f32x4*)b + lane;
    GAS f32x4* p0 = (GAS f32x4*)o0 + lane; GAS f32x4* p1 = (GAS f32x4*)o1 + lane;
#pragma unroll
    for (int j = 0; j < 16; ++j) { if ((j & 3) == 0) asm volatile("" ::: "memory");
        const f32x4 gg = gr[64 * j], bb = br[64 * j]; p0[64 * j] = v[j] * rs0 * gg + bb; p1[64 * j] = w[j] * rs1 * gg + bb; }
}
struct Args { const float* in[18]; float* out; unsigned char* ws; };
constexpr int I_GU = (DM / 64) * (FF / 64), I_D = (FF / 64) * (DM / 64), I_IN = (DM / 64) * (NIN / 64), I_OUT = (DM / 64) * (DM / 64);
constexpr int IT_R0 = 2 * I_GU + I_IN + I_OUT, IT_R1 = IT_R0 + I_D, IT_R2 = IT_R1 + 2 * I_GU, IT_R3 = IT_R2 + I_D;
__device__ __forceinline__ P0Item decode_item(const Args& args, int it, int lane) {
    unsigned char* ws = args.ws; int r = it; float* cv = (float*)(ws + WS_CV);
    if (r < I_GU) return p0_item(args.in[1], DM, FF, (bf16*)(ws + WS_WGU1), true, 0, r); r -= I_GU;
    if (r < I_GU) return p0_item(args.in[2], DM, FF, (bf16*)(ws + WS_WGU1), true, 1, r); r -= I_GU;
    if (r < I_IN) return p0_item(args.in[6], DM, NIN, (bf16*)(ws + WS_WIN), false, 0, r, args.in[4], args.in[5], cv, cv + NIN); r -= I_IN;
    if (r < I_OUT) return p0_item(args.in[10], DM, DM, (bf16*)(ws + WS_WOUT), false, 0, r); r -= I_OUT;
    if (r < I_D) return p0_item(args.in[3], FF, DM, (bf16*)(ws + WS_WD1), false, 0, r); r -= I_D;
    if (r < I_GU) return p0_item(args.in[13], DM, FF, (bf16*)(ws + WS_WGU2), true, 0, r, args.in[11], args.in[12], cv + 2 * NIN, cv + 2 * NIN + NGU); r -= I_GU;
    if (r < I_GU) return p0_item(args.in[14], DM, FF, (bf16*)(ws + WS_WGU2), true, 1, r, args.in[11], args.in[12], cv + 2 * NIN, cv + 2 * NIN + NGU); r -= I_GU;
    return p0_item(args.in[15], FF, DM, (bf16*)(ws + WS_WD2), false, 0, r);
}
template <bool NTS> __device__ __forceinline__ void convert_items(const Args& args, int first, int end, int widx, int wstride, LAS float* scr, int lane) {
    f32x4 va[16], vb[16]; P0Item ia, ib; int it = first + widx;
    if (it < end) { ia = decode_item(args, it, lane); p0_load(va, ia, lane); }
    while (it < end) {
        const int it1 = it + wstride, it2 = it + 2 * wstride;
        if (it1 < end) { ib = decode_item(args, it1, lane); p0_load(vb, ib, lane); }
        p0_store<NTS>(va, ia, scr, lane);
        if (it1 >= end) break;
        if (it2 < end) { ia = decode_item(args, it2, lane); p0_load(va, ia, lane); }
        p0_store<NTS>(vb, ib, scr, lane);
        it = it2;
    }
}
__device__ __forceinline__ const Args* kargs() { auto p = __builtin_amdgcn_kernarg_segment_ptr(); asm volatile("" : "+s"(p)); return (const Args*)p; }
#define KARGS() const Args* pa = kargs(); (void)pa
#define MIXA_FIXM(out) bool out; { float gq_ = fmaxf(fabsf(pa->in[7][lane]), fabsf(pa->in[7][lane + 64])), gk_ = fmaxf(fabsf(pa->in[8][lane]), fabsf(pa->in[8][lane + 64])); \
    _Pragma("unroll") for (int o_ = 1; o_ < 64; o_ <<= 1) { gq_ = fmaxf(gq_, __shfl_xor(gq_, o_)); gk_ = fmaxf(gk_, __shfl_xor(gk_, o_)); } \
    out = __builtin_amdgcn_readfirstlane((att::SCALE * att::LOG2E * 128.0f * gq_ * gk_ < 60.0f) ? 1 : 0) != 0; }
#define WS_ (pa->ws)
#define Wgu1 ((bf16*)(WS_ + WS_WGU1))
#define Wd1 ((bf16*)(WS_ + WS_WD1))
#define Win ((bf16*)(WS_ + WS_WIN))
#define Wout ((bf16*)(WS_ + WS_WOUT))
#define Wgu2 ((bf16*)(WS_ + WS_WGU2))
#define Wd2 ((bf16*)(WS_ + WS_WD2))
#define XB ((bf16*)(WS_ + WS_XB))
#define ACT ((bf16*)(WS_ + WS_ACT))
#define PROJ ACT
#define AO XB
#define YB ((bf16*)(WS_ + WS_HB))
#define Y ((float*)(WS_ + WS_Y))
#define STAT0 ((float*)(WS_ + WS_STAT))
#define STAT1 (STAT0 + 2 * SEQ)
#define CV ((float*)(WS_ + WS_CV))
#define ROPE ((float*)(WS_ + WS_ROPE))
#define TB ((float*)(WS_ + WS_TB))
__global__ void __launch_bounds__(NWAVES * 64, 2) fwd_kernel(Args args) {
    extern __shared__ __attribute__((aligned(16))) unsigned char lds[];
    LAS unsigned char* ldsl = (LAS unsigned char*)lds;
#define PHASE_TID() int tid_ = threadIdx.x; asm volatile("" : "+v"(tid_)); const int tid = tid_, lane = tid & 63, wave = __builtin_amdgcn_readfirstlane(tid >> 6), gw = vcu * NWAVES + wave; (void)lane; (void)gw; (void)tid
    const int G = gridDim.x, bx = blockIdx.x, vcu = (G % 8 == 0) ? (bx % 8) * (G / 8) + bx / 8 : bx;
    const int NGW = G * NWAVES;
    { int t0_ = threadIdx.x; asm volatile("" : "+v"(t0_)); for (int u = t0_; u < (LDS_BYTES - LDSCTL_OFF) / 4; u += NWAVES * 64) ((LAS unsigned*)(ldsl + LDSCTL_OFF))[u] = 0u; }
    __syncthreads();
    XcdBarrier bar; { KARGS(); bar = xcd_barrier_post((unsigned*)((gu32*)(WS_ + WS_CTL) + CW_BAR), (volatile LAS unsigned*)(ldsl + LDSCTL_OFF + 32)); }

    {
        KARGS(); PHASE_TID();
        LAS float* scr = (LAS float*)(ldsl + wave * P0_SCR_PER_WAVE);
        convert_items<false>(*pa, 0, IT_R3, gw, NGW, scr, lane);
        const size_t n8 = (size_t)SEQ * DM / 8;
        for (size_t i0 = (size_t)gw * 64 + lane; i0 < n8; i0 += (size_t)NGW * 64 * 4) {
            f32x4 a[4], b[4];
#pragma unroll
            for (int r = 0; r < 4; ++r) { const size_t i = i0 + (size_t)r * NGW * 64; if (i < n8) { a[r] = __builtin_nontemporal_load((const GAS f32x4*)(pa->in[0] + i * 8)); b[r] = __builtin_nontemporal_load((const GAS f32x4*)(pa->in[0] + i * 8 + 4)); } }
#pragma unroll
            for (int r = 0; r < 4; ++r) { const size_t i = i0 + (size_t)r * NGW * 64; if (i < n8) {
                v4u o; o.x = pk2(a[r].x, a[r].y); o.y = pk2(a[r].z, a[r].w); o.z = pk2(b[r].x, b[r].y); o.w = pk2(b[r].z, b[r].w);
                *(GAS v4u*)(XB + pg8::blk_off((int)(i / (DM / 8)), (int)(i % (DM / 8)) * 8, DM)) = o; } }
        }
        for (int e = bx * (NWAVES * 64) + tid; e < 128 * 32; e += G * NWAVES * 64) {
            const int pos = e >> 5, i = e & 31; const float inv = powf(10000.0f, -(float)(2 * i) / 64.0f); const float ang = (float)pos * inv;
            ROPE[2 * e] = cosf(ang); ROPE[2 * e + 1] = sinf(ang); }
        for (int e = bx * (NWAVES * 64) + tid; e < 16 * att::TBN; e += G * NWAVES * 64) {
            const int h = e / att::TBN, d = e % att::TBN - att::TB0; const int ad = d < 0 ? -d : d;
            const int cnt = (ad <= 64 ? 1 : 0) + (((ad & 3) == 0 && ad <= 256) ? 1 : 0) + (((ad & 15) == 0 && ad <= 1024) ? 1 : 0);
            float v = -INFINITY;
            if (cnt > 0) v = (pa->in[9][t5_bucket(d) * 16 + h] + logf((float)cnt)) * 1.4426950408889634f;
            TB[e] = v; }
    }
    xcd_barrier(bar);

    { KARGS(); pg8::Gemm g{XB, Wgu1, SEQ, NGU, DM}; pg8::StaticOrder S; S.init(SEQ, NGU, G, bx);
      pg8::EpiSwiGLU E{ACT, FF, 1.0f};
      pg8::gemm_phase<pg8::EpiSwiGLU, pg8::StaticOrder, true, true>(ldsl + RING_OFF, g, S, E); }
    xcd_barrier(bar);
    { KARGS(); pg8::Gemm g{ACT, Wd1, SEQ, DM, FF}; pg8::StaticOrder S; S.init(SEQ, DM, G, bx);
      typedef pg8::EpiResN<false, true, true, 1> Epi; Epi E{pa->in[0], Y, YB, nullptr, nullptr, nullptr, STAT0};
      pg8::gemm_phase<Epi, pg8::StaticOrder, true, true>(ldsl + RING_OFF, g, S, E); }
    xcd_barrier(bar);
    { KARGS(); pg8::Gemm g{YB, Win, SEQ, NIN, DM}; pg8::StaticOrder S; S.init(SEQ, NIN, G, bx);
      pg8::EpiBf16HeadsN E{PROJ, SEQ, STAT0, CV, CV + NIN};
      pg8::gemm_phase<pg8::EpiBf16HeadsN, pg8::StaticOrder, true, true>(ldsl + RING_OFF, g, S, E); }
    xcd_barrier(bar);
    {
        KARGS(); PHASE_TID();
        const float* qg = pa->in[7]; const float* kg = pa->in[8];
        const float qg0 = qg[2 * lane], qg1 = qg[2 * lane + 1], kg0 = kg[2 * lane], kg1 = kg[2 * lane + 1];
        MIXA_FIXM(fixm);
        for (int base = gw; base < 20 * SEQ; base += 8 * NGW) {
            unsigned w[8];
#pragma unroll
            for (int r = 0; r < 8; ++r) { const int idx = base + r * NGW; w[r] = idx < 20 * SEQ ? *((const GAS unsigned*)(PROJ + (size_t)idx * 128) + lane) : 0u; }
#pragma unroll
            for (int r = 0; r < 8; ++r) { const int idx = base + r * NGW; if (idx >= 20 * SEQ) break;
                const int hh = idx / SEQ, t = idx - hh * SEQ;
                const int pos = lane < 32 ? (t >> 6) : (t & 63), fi = lane & 31;
                const float c = ROPE[2 * (pos * 32 + fi)], s = ROPE[2 * (pos * 32 + fi) + 1];
                const float x1 = __uint_as_float(w[r] << 16), x2 = __uint_as_float(w[r] & 0xffff0000u);
                const float ss = wave_sum(x1 * x1 + x2 * x2);
                const float rs = 1.0f / sqrtf(ss * (1.0f / 128.0f) + RMS_EPS);
                const float qs = (hh < 16 && fixm) ? att::SCALE * att::LOG2E : 1.0f;
                const float n1 = x1 * rs * (hh < 16 ? qg0 : kg0) * qs, n2 = x2 * rs * (hh < 16 ? qg1 : kg1) * qs;
                *((GAS unsigned*)(PROJ + (size_t)idx * 128) + lane) = pk2(n1 * c - n2 * s, n1 * s + n2 * c); }
        }
    }
    xcd_barrier(bar);
    {
        KARGS(); PHASE_TID();
        MIXA_FIXM(fixm);
        if (fixm) {
            for (int u = vcu; u < 512; u += G) { const int head = u >> 5, qblk = u & 31, P0 = qblk * 256, kvh = head >> 2;
                att::attn_body<false, 2, true>(PROJ + ((size_t)(HQA + head) * SEQ + P0) * 128, PROJ + (size_t)(HKA + kvh) * SEQ * 128, PROJ + (size_t)(HVA + kvh) * SEQ * 128, AO + pg8::blk_off(P0, head * 128, DM), SEQ / 64, 0, (char*)lds); }
        }
        for (int u = vcu + (fixm ? 512 : 0); u < 1024; u += G) {
            const bool isB = u >= 512; const int head = (u & 511) >> 5, qblk = u & 31, P0 = qblk * 256;
            for (int e = tid; e < att::TBN; e += NWAVES * 64) ((LAS float*)(ldsl + att::OFF_TB))[e] = isB ? TB[head * att::TBN + e] : 0.f;
            const int ks = isB ? (P0 - 1024 < 0 ? 0 : P0 - 1024) : 0, ke = isB ? (P0 + 1280 > SEQ ? SEQ : P0 + 1280) : SEQ;
            const int hq = isB ? HQB + head : HQA + head, hk = isB ? HKB + head : HKA + (head >> 2), hv = isB ? HVB + head : HVA + (head >> 2);
            att::attn_body<true, 1>(PROJ + ((size_t)hq * SEQ + P0) * 128, PROJ + ((size_t)hk * SEQ + ks) * 128, PROJ + ((size_t)hv * SEQ + ks) * 128,
                                    AO + pg8::blk_off(P0, (isB ? 2048 : 0) + head * 128, DM), (ke - ks) / 64, isB ? ks - P0 : 0, (char*)lds, isB ? att::KVBLK : 0);
        }
    }
    xcd_barrier(bar);
    { KARGS(); pg8::Gemm g{AO, Wout, SEQ, DM, DM}; pg8::StaticOrder S; S.init(SEQ, DM, G, bx);
      typedef pg8::EpiResN<true, true, true, 2> Epi; Epi E{Y, Y, YB, STAT0, pa->in[4], pa->in[5], STAT1};
      pg8::gemm_phase<Epi, pg8::StaticOrder, true, true>(ldsl + RING_OFF, g, S, E); }
    xcd_barrier(bar);
    { KARGS(); pg8::Gemm g{YB, Wgu2, SEQ, NGU, DM}; pg8::StaticOrder S; S.init(SEQ, NGU, G, bx);
      pg8::EpiSwiGLUN E{ACT, FF, STAT1, CV + 2 * NIN, CV + 2 * NIN + NGU};
      pg8::gemm_phase<pg8::EpiSwiGLUN, pg8::StaticOrder, true, true>(ldsl + RING_OFF, g, S, E); }
    xcd_barrier(bar);
    { KARGS(); pg8::Gemm g{ACT, Wd2, SEQ, DM, FF}; pg8::StaticOrder S; S.init(SEQ, DM, G, bx);
      typedef pg8::EpiResN<true, false, false, 1> Epi; Epi E{Y, Y, nullptr, STAT1, pa->in[11], pa->in[12], nullptr};
      pg8::gemm_phase<Epi, pg8::StaticOrder, true, true>(ldsl + RING_OFF, g, S, E); }
    xcd_barrier(bar);
    { KARGS(); PHASE_TID();
    for (int m = gw; m + NGW < SEQ; m += 2 * NGW) ln_rows2(Y + (size_t)m * DM, Y + (size_t)(m + NGW) * DM, pa->in[16], pa->in[17], pa->out + (size_t)m * DM, pa->out + (size_t)(m + NGW) * DM, lane);
    }
}

extern "C" void kernel_launch(void* const* d_in, const int* in_sizes, int n_in, void* d_out, int out_size, void* d_ws, size_t ws_size, hipStream_t stream) {
    static int grid = 0;
    if (grid == 0) {
        if (n_in != 18 || in_sizes[0] != SEQ * DM || out_size != SEQ * DM || ws_size < WS_END) {
            fprintf(stderr, "kernel_launch: built for 18 inputs, x/out of %d floats, >= %zu bytes of workspace; got n_in %d, in0 %d, out %d, ws %zu; nothing launched\n", SEQ * DM, (size_t)WS_END, n_in, n_in > 0 ? in_sizes[0] : -1, out_size, ws_size);
            grid = -1; return; }
        int dev = 0, cus = 0, per_cu = 0;
        if (hipGetDevice(&dev) != hipSuccess || hipDeviceGetAttribute(&cus, hipDeviceAttributeMultiprocessorCount, dev) != hipSuccess) { fprintf(stderr, "kernel_launch: device query failed\n"); grid = -1; return; }
        if (hipFuncSetAttribute((const void*)fwd_kernel, hipFuncAttributeMaxDynamicSharedMemorySize, LDS_BYTES) != hipSuccess) { fprintf(stderr, "kernel_launch: hipFuncSetAttribute failed\n"); grid = -1; return; }
        if (hipOccupancyMaxActiveBlocksPerMultiprocessor(&per_cu, (const void*)fwd_kernel, NWAVES * 64, LDS_BYTES) != hipSuccess || per_cu < 1)
            fprintf(stderr, "kernel_launch: note: occupancy query reports %d workgroups per CU\n", per_cu);
        (void)hipGetLastError();
        grid = cus;
    }
    if (grid < 0) return;
    if (hipMemsetAsync((char*)d_ws + WS_CTL, 0, CTL_ZERO_BYTES, stream) != hipSuccess) { fprintf(stderr, "kernel_launch: hipMemsetAsync failed\n"); return; }
    Args a{};
    for (int i = 0; i < 18; ++i) a.in[i] = (const float*)d_in[i];
    a.out = (float*)d_out; a.ws = (unsigned char*)d_ws;
    hipLaunchKernelGGL(fwd_kernel, dim3(grid), dim3(NWAVES * 64), LDS_BYTES, stream, a);
    const hipError_t le = hipPeekAtLastError();
    if (le != hipSuccess) fprintf(stderr, "kernel_launch: launch failed: %s\n", hipGetErrorName(le));
}
```
